# Optimizing an MI355X kernel written in HIP

```python
import jax, jax.numpy as jnp
from jax import lax
import numpy as np

D_MODEL = 1024
BATCH = 2
SEQ = 8192
DEPTH = 4

EPS = 1e-5
HEAD_DIM = 64
SSD_HEADS = 8
SSD_WIDTH = SSD_HEADS * HEAD_DIM
SSD_GROUPS = 2
SSD_STATE = 128
SSD_CHUNK = 128
CONV_K = 4
XBC_WIDTH = SSD_WIDTH + 2 * SSD_GROUPS * SSD_STATE
MOBA_HEADS = 4
MOBA_WIDTH = MOBA_HEADS * HEAD_DIM
MOBA_BLOCK = 256
MOBA_TOPK = 3
MOBA_QBLOCK = 64
SWA_HEADS = 4
SWA_KV_HEADS = 2
SWA_WIDTH = SWA_HEADS * HEAD_DIM
SWA_KV_WIDTH = SWA_KV_HEADS * HEAD_DIM
SWA_WINDOW = 128
SWA_BLOCK = 128
MIX_WIDTH = SSD_WIDTH + MOBA_WIDTH + SWA_WIDTH
N_IN = SSD_WIDTH + XBC_WIDTH + SSD_HEADS + 3 * MOBA_WIDTH + SWA_WIDTH + 2 * SWA_KV_WIDTH
PEER_HEADS = 8
PEER_TOPK = 16
PEER_NKEYS = 128
PEER_EXPERTS = PEER_NKEYS * PEER_NKEYS
PEER_DKEY = 256
PEER_HALF = PEER_DKEY // 2
PEER_CHUNK = 128

kernel_name = "hymba_ssd_moba_swa_peer_adaln"


def rms_norm(x, g):
    x32 = x.astype(jnp.float32)
    y = x32 * lax.rsqrt(jnp.mean(x32 * x32, axis=-1, keepdims=True) + EPS)
    return y.astype(x.dtype) * g.astype(x.dtype)


def causal_depthwise_conv(x, w, b):
    y = lax.conv_general_dilated(
        x, w.astype(x.dtype)[:, None, :], window_strides=(1,), padding=[(CONV_K - 1, 0)],
        dimension_numbers=("NWC", "WIO", "NWC"), feature_group_count=x.shape[-1])
    return y + b.astype(x.dtype)


def segsum(a):
    t = a.shape[-1]
    xr = jnp.broadcast_to(a[..., None], a.shape + (t,))
    xr = jnp.where(jnp.tril(jnp.ones((t, t), bool), -1), xr, 0.0)
    cs = jnp.cumsum(xr, axis=-2)
    return jnp.where(jnp.tril(jnp.ones((t, t), bool)), cs, -jnp.inf)


def ssd_mixer(z, xbc, dt_raw, conv_w, conv_b, dt_bias, a_log, d_skip, norm_g):
    f32 = jnp.float32
    b, s, _ = z.shape
    G, R, L, P, N = SSD_GROUPS, SSD_HEADS // SSD_GROUPS, SSD_CHUNK, HEAD_DIM, SSD_STATE
    nc = s // L
    xbc = jax.nn.silu(causal_depthwise_conv(xbc, conv_w, conv_b))
    xs, bm, cm = jnp.split(xbc, [SSD_WIDTH, SSD_WIDTH + G * N], axis=-1)
    dt = jax.nn.softplus(dt_raw.astype(f32) + dt_bias.astype(f32))
    a_head = -jnp.exp(a_log.astype(f32))
    xh = xs.reshape(b, nc, L, G, R, P)
    xdt = xh.astype(f32) * dt.reshape(b, nc, L, G, R)[..., None]
    bc = bm.reshape(b, nc, L, G, N)
    cc = cm.reshape(b, nc, L, G, N)
    a = (dt * a_head).reshape(b, nc, L, G, R).transpose(0, 3, 4, 1, 2)
    a_cs = jnp.cumsum(a, axis=-1)
    decay = jnp.exp(segsum(a))
    cb = jnp.einsum("bclgn,bcsgn->bgcls", cc, bc)
    y_diag = jnp.einsum("bgcls,bgrcls,bcsgrp->bclgrp", cb, decay, xdt)
    decay_states = jnp.exp(a_cs[..., -1:] - a_cs)
    states = jnp.einsum("bclgn,bgrcl,bclgrp->bcgrpn", bc, decay_states, xdt)
    states = jnp.concatenate([jnp.zeros_like(states[:, :1]), states], axis=1)
    last = jnp.pad(a_cs[..., -1], ((0, 0), (0, 0), (0, 0), (1, 0)))
    chunk_decay = jnp.exp(segsum(last))
    states = jnp.einsum("bgrzc,bcgrpn->bzgrpn", chunk_decay, states)[:, :-1]
    y_off = jnp.einsum("bclgn,bcgrpn,bgrcl->bclgrp", cc, states, jnp.exp(a_cs))
    y = (y_diag + y_off).reshape(b, s, SSD_HEADS, P) \
        + d_skip.astype(f32)[:, None] * xs.reshape(b, s, SSD_HEADS, P).astype(f32)
    y = y.reshape(b, s, SSD_WIDTH).astype(z.dtype)
    return rms_norm(y * jax.nn.silu(z), norm_g)


def moba_attention(q, k, v, norm_g):
    f32 = jnp.float32
    b, s, _ = q.shape
    H, Dh, BL, QB = MOBA_HEADS, HEAD_DIM, MOBA_BLOCK, MOBA_QBLOCK
    nb = -(-s // BL)
    pad = nb * BL - s
    q, k, v = (t.reshape(b, s, H, Dh).transpose(0, 2, 1, 3) for t in (q, k, v))
    k = jnp.pad(k, ((0, 0), (0, 0), (0, pad), (0, 0)))
    v = jnp.pad(v, ((0, 0), (0, 0), (0, pad), (0, 0)))
    kb = k.reshape(b, H, nb, BL, Dh)
    vb = v.reshape(b, H, nb, BL, Dh)
    k_mean = jnp.mean(kb.astype(f32), axis=3)
    gate = jnp.einsum("bhsd,bhnd->bhsn", q.astype(f32), k_mean)
    past = jnp.arange(nb)[None, :] < (jnp.arange(s) // BL)[:, None]
    gate = jnp.where(past, gate, -jnp.inf)
    topk = min(MOBA_TOPK, nb)
    _, sel = lax.top_k(gate, topk)
    nq = s // QB
    q_chunks = q.reshape(b, H, nq, QB, Dh).transpose(2, 0, 1, 3, 4)
    sel_chunks = sel.reshape(b, H, nq, QB, topk).transpose(2, 0, 1, 3, 4)
    bi = jnp.arange(b)[:, None, None, None]
    hi = jnp.arange(H)[None, :, None, None]
    scale = Dh ** -0.5

    def one_chunk(args):
        qc, selc, ci = args
        q0 = ci * QB
        blk = q0 // BL
        q_pos = q0 + jnp.arange(QB)
        k_sel = kb[bi, hi, selc]
        v_sel = vb[bi, hi, selc]
        s_sel = jnp.einsum("bhqd,bhqjkd->bhqjk", qc, k_sel).astype(f32) * scale
        valid = jnp.arange(topk) < blk
        s_sel = jnp.where(valid[:, None], s_sel, -jnp.inf).reshape(b, H, QB, topk * BL)
        start = blk * BL
        k_own = lax.dynamic_slice_in_dim(k, start, BL, axis=2)
        v_own = lax.dynamic_slice_in_dim(v, start, BL, axis=2)
        s_own = jnp.einsum("bhqd,bhkd->bhqk", qc, k_own).astype(f32) * scale
        k_pos = start + jnp.arange(BL)
        s_own = jnp.where(k_pos[None, :] <= q_pos[:, None], s_own, -jnp.inf)
        p = jax.nn.softmax(jnp.concatenate([s_sel, s_own], axis=-1), axis=-1).astype(v.dtype)
        p_sel = p[..., :topk * BL].reshape(b, H, QB, topk, BL)
        p_own = p[..., topk * BL:]
        return jnp.einsum("bhqjk,bhqjkd->bhqd", p_sel, v_sel) + jnp.einsum("bhqk,bhkd->bhqd", p_own, v_own)

    out = lax.map(one_chunk, (q_chunks, sel_chunks, jnp.arange(nq)))
    out = out.transpose(1, 0, 3, 2, 4).reshape(b, s, H * Dh)
    return rms_norm(out, norm_g)


def swa_attention(q, k, v, sinks, norm_g):
    f32 = jnp.float32
    b, s, _ = q.shape
    W, G, R, Dh = SWA_BLOCK, SWA_KV_HEADS, SWA_HEADS // SWA_KV_HEADS, HEAD_DIM
    nb = s // W
    qb = q.reshape(b, nb, W, G, R, Dh)
    kb = k.reshape(b, nb, W, G, Dh)
    vb = v.reshape(b, nb, W, G, Dh)
    shift = lambda t: jnp.concatenate([jnp.zeros_like(t[:, :1]), t[:, :-1]], axis=1)
    k_band = jnp.concatenate([shift(kb), kb], axis=2)
    v_band = jnp.concatenate([shift(vb), vb], axis=2)
    scores = jnp.einsum("bnqgrd,bnkgd->bngrqk", qb, k_band).astype(f32) * (Dh ** -0.5)
    i = jnp.arange(W)[:, None]
    j = jnp.arange(2 * W)[None, :]
    rel = i + W - j
    in_win = (rel >= 0) & (rel < SWA_WINDOW)
    has_prev = (jnp.arange(nb) > 0)[:, None, None] | (j >= W)[None]
    mask = in_win[None] & has_prev
    scores = jnp.where(mask[None, :, None, None], scores, -jnp.inf)
    sink = jnp.broadcast_to(sinks.astype(f32).reshape(G, R)[None, None, :, :, None, None],
                            scores.shape[:-1] + (1,))
    p = jax.nn.softmax(jnp.concatenate([scores, sink], axis=-1), axis=-1)[..., :-1].astype(v.dtype)
    out = jnp.einsum("bngrqk,bnkgd->bnqgrd", p, v_band).reshape(b, s, SWA_WIDTH)
    return rms_norm(out, norm_g)


def peer_ffn(h, wq, k1, k2, u, v):
    f32 = jnp.float32
    b, s, d = h.shape
    nch = (b * s) // PEER_CHUNK
    hc = h.reshape(nch, PEER_CHUNK, d)

    def one_chunk(xc):
        q = (xc @ wq).reshape(PEER_CHUNK, PEER_HEADS, 2, PEER_HALF).astype(f32)
        s1 = jnp.einsum("thd,nd->thn", q[:, :, 0], k1.astype(f32))
        s2 = jnp.einsum("thd,nd->thn", q[:, :, 1], k2.astype(f32))
        v1, i1 = lax.top_k(s1, PEER_TOPK)
        v2, i2 = lax.top_k(s2, PEER_TOPK)
        cand = (v1[..., :, None] + v2[..., None, :]).reshape(PEER_CHUNK, PEER_HEADS, PEER_TOPK * PEER_TOPK)
        sc, ci = lax.top_k(cand, PEER_TOPK)
        e = jnp.take_along_axis(i1, ci // PEER_TOPK, axis=-1) * PEER_NKEYS \
            + jnp.take_along_axis(i2, ci % PEER_TOPK, axis=-1)
        g = jax.nn.softmax(sc, axis=-1)
        u_sel = u[e]
        v_sel = v[e]
        pre = jnp.einsum("td,thkd->thk", xc, u_sel).astype(f32)
        act = (jax.nn.gelu(pre, approximate=False) * g).astype(v.dtype)
        return jnp.einsum("thk,thkd->td", act, v_sel)

    return lax.map(one_chunk, hc).reshape(b, s, d)


def setup_inputs(seed: int = 0) -> dict:
    key = jax.random.key(seed)
    ks = jax.random.split(key, 24)
    f32 = jnp.float32
    nrm = lambda k, shape, scale: jax.random.normal(k, shape, f32) * scale
    L, D = DEPTH, D_MODEL
    dt0 = jnp.exp(jax.random.uniform(ks[8], (L, SSD_HEADS), f32) * (np.log(0.1) - np.log(0.001)) + np.log(0.001))
    return {
        "x": nrm(ks[0], (BATCH, SEQ, D), 1.0),
        "c": nrm(ks[1], (BATCH, D), 1.0),
        "ada_w": nrm(ks[2], (L, D, 6 * D), 0.5 * D ** -0.5),
        "ada_b": nrm(ks[3], (L, 6 * D), 0.01),
        "norm1_g": 1.0 + nrm(ks[4], (L, D), 0.02),
        "norm2_g": 1.0 + nrm(ks[5], (L, D), 0.02),
        "w_in": nrm(ks[6], (L, D, N_IN), D ** -0.5),
        "conv_w": nrm(ks[7], (L, CONV_K, XBC_WIDTH), CONV_K ** -0.5),
        "conv_b": nrm(ks[9], (L, XBC_WIDTH), 0.01),
        "dt_bias": dt0 + jnp.log(-jnp.expm1(-dt0)),
        "a_log": jnp.log(jax.random.uniform(ks[10], (L, SSD_HEADS), f32, 1.0, 16.0)),
        "d_skip": 1.0 + nrm(ks[11], (L, SSD_HEADS), 0.1),
        "ssd_norm_g": 1.0 + nrm(ks[12], (L, SSD_WIDTH), 0.02),
        "moba_norm_g": 1.0 + nrm(ks[13], (L, MOBA_WIDTH), 0.02),
        "swa_sinks": nrm(ks[14], (L, SWA_HEADS), 0.5),
        "swa_norm_g": 1.0 + nrm(ks[15], (L, SWA_WIDTH), 0.02),
        "w_out": nrm(ks[16], (L, MIX_WIDTH, D), MIX_WIDTH ** -0.5),
        "peer_wq": nrm(ks[17], (L, D, PEER_HEADS * PEER_DKEY), D ** -0.5),
        "peer_k1": nrm(ks[18], (L, PEER_NKEYS, PEER_HALF), PEER_HALF ** -0.5),
        "peer_k2": nrm(ks[19], (L, PEER_NKEYS, PEER_HALF), PEER_HALF ** -0.5),
        "peer_u": nrm(ks[20], (L, PEER_EXPERTS, D), D ** -0.5),
        "peer_v": nrm(ks[21], (L, PEER_EXPERTS, D), PEER_HEADS ** -0.5),
        "final_g": 1.0 + nrm(ks[22], (D,), 0.02),
    }


def reference(x, c, ada_w, ada_b, norm1_g, norm2_g, w_in, conv_w, conv_b, dt_bias, a_log, d_skip,
              ssd_norm_g, moba_norm_g, swa_sinks, swa_norm_g, w_out, peer_wq, peer_k1, peer_k2,
              peer_u, peer_v, final_g):
    in_widths = [SSD_WIDTH, XBC_WIDTH, SSD_HEADS, MOBA_WIDTH, MOBA_WIDTH, MOBA_WIDTH,
                 SWA_WIDTH, SWA_KV_WIDTH, SWA_KV_WIDTH]
    offsets = np.cumsum(in_widths)[:-1].tolist()
    cond = jax.nn.silu(c)
    for l in range(DEPTH):
        mod = cond @ ada_w[l] + ada_b[l]
        sh1, sc1, g1, sh2, sc2, g2 = [m[:, None, :] for m in jnp.split(mod, 6, axis=-1)]
        h = rms_norm(x, norm1_g[l]) * (1.0 + sc1) + sh1
        proj = h @ w_in[l]
        z, xbc, dt_raw, mq, mk, mv, sq, sk, sv = jnp.split(proj, offsets, axis=-1)
        y_ssd = ssd_mixer(z, xbc, dt_raw, conv_w[l], conv_b[l], dt_bias[l], a_log[l], d_skip[l], ssd_norm_g[l])
        y_moba = moba_attention(mq, mk, mv, moba_norm_g[l])
        y_swa = swa_attention(sq, sk, sv, swa_sinks[l], swa_norm_g[l])
        y = jnp.concatenate([y_ssd, y_moba, y_swa], axis=-1) @ w_out[l]
        x = x + g1 * y
        h = rms_norm(x, norm2_g[l]) * (1.0 + sc2) + sh2
        x = x + g2 * peer_ffn(h, peer_wq[l], peer_k1[l], peer_k2[l], peer_u[l], peer_v[l])
    return rms_norm(x, final_g)
```

```cpp
#include <hip/hip_runtime.h>
#include <hip/hip_cooperative_groups.h>
#include <cstdio>
#include <cstdint>
#include <cstring>
namespace cg = cooperative_groups;

constexpr int D = 1024, NB = 2, S = 8192, T = NB * S, NL = 4;
constexpr int NIN = 2824;
constexpr int C_Z = 0, C_XBC = 512, C_DT = 1536, C_MQ = 1544, C_MK = 1800, C_MV = 2056, C_SQ = 2312, C_SK = 2568, C_SV = 2696;
constexpr int NTHR = 256;

struct Params {
  const float *x, *c, *ada_w, *ada_b, *norm1_g, *norm2_g, *w_in, *conv_w, *conv_b, *dt_bias, *a_log, *d_skip,
      *ssd_norm_g, *moba_norm_g, *swa_sinks, *swa_norm_g, *w_out, *peer_wq, *peer_k1, *peer_k2, *peer_u, *peer_v, *final_g;
  float* out;
  char* ws;
};
constexpr size_t al256(size_t x) { return (x + 255) & ~(size_t)255; }
constexpr size_t OFF_MOD = 0;
constexpr size_t OFF_KMEAN = OFF_MOD + al256((size_t)NL * 2 * 6 * D * 4);
constexpr size_t OFF_XCUR = OFF_KMEAN + al256((size_t)NB * 4 * 32 * 64 * 4);
constexpr size_t OFF_H = OFF_XCUR + al256((size_t)T * D * 4);
constexpr size_t OFF_PROJ = OFF_H + al256((size_t)T * D * 4);
constexpr size_t OFF_XBC = OFF_PROJ + al256((size_t)T * NIN * 4);
constexpr size_t OFF_DTB = OFF_XBC + al256((size_t)T * 1024 * 4);
constexpr size_t OFF_ACS = OFF_DTB + al256((size_t)T * 8 * 4);
constexpr size_t OFF_CB = OFF_ACS + al256((size_t)T * 8 * 4);
constexpr size_t OFF_YBUF = OFF_CB + al256((size_t)NB * 64 * 2 * 128 * 128 * 4);
constexpr size_t OFF_STATES = OFF_YBUF + al256((size_t)T * 512 * 4);
constexpr size_t OFF_YCAT = OFF_STATES + al256((size_t)NB * 64 * 8 * 64 * 128 * 4);
constexpr size_t OFF_EIDX = OFF_YCAT + al256((size_t)T * 1024 * 4);
constexpr size_t OFF_GVAL = OFF_EIDX + al256((size_t)T * 128 * 4);
constexpr size_t WS_TOTAL = OFF_GVAL + al256((size_t)T * 128 * 4);
constexpr size_t OFF_QBUF = OFF_PROJ;
constexpr size_t OFF_S1 = OFF_XBC;
constexpr size_t OFF_S2 = OFF_YCAT;
#define WSF(name) ((float*)(p.ws + OFF_##name))
#define WSI(name) ((int*)(p.ws + OFF_##name))

__device__ __forceinline__ float siluf(float x) { return x / (1.f + expf(-x)); }
__device__ __forceinline__ float wave_sum(float v) {
#pragma unroll
  for (int o = 32; o > 0; o >>= 1) v += __shfl_xor(v, o);
  return v;
}
__device__ __forceinline__ void wave_argmax(float& v, int& i) {
#pragma unroll
  for (int o = 32; o > 0; o >>= 1) {
    float ov = __shfl_xor(v, o);
    int oi = __shfl_xor(i, o);
    if (ov > v || (ov == v && oi < i)) { v = ov; i = oi; }
  }
}

__device__ void phase_mod(const Params& p, float* smem) {
  for (int i = threadIdx.x; i < NB * D; i += NTHR) smem[i] = siluf(p.c[i]);
  __syncthreads();
  const int gtid = blockIdx.x * NTHR + threadIdx.x, gsz = gridDim.x * NTHR;
  for (int idx = gtid; idx < NL * 6 * D; idx += gsz) {
    const int l = idx / (6 * D), j = idx % (6 * D);
    const float* w = p.ada_w + (size_t)l * D * 6 * D + j;
    float a0 = 0.f, a1 = 0.f;
    for (int k = 0; k < D; ++k) { const float wv = w[(size_t)k * 6 * D]; a0 += smem[k] * wv; a1 += smem[D + k] * wv; }
    const float bb = p.ada_b[l * 6 * D + j];
    WSF(MOD)[(l * 2 + 0) * 6 * D + j] = a0 + bb;
    WSF(MOD)[(l * 2 + 1) * 6 * D + j] = a1 + bb;
  }
  const float4* xs = (const float4*)p.x; float4* xd = (float4*)WSF(XCUR);
  for (int i = gtid; i < T * D / 4; i += gsz) xd[i] = xs[i];
  __syncthreads();
}

__device__ void phase_norm_mod(const float* xin, const float* g, const float* sc, const float* sh, float* hout) {
  const int wave = (blockIdx.x * NTHR + threadIdx.x) >> 6, nw = gridDim.x * (NTHR / 64), lane = threadIdx.x & 63;
  for (int t = wave; t < T; t += nw) {
    const float4* xr = (const float4*)(xin + (size_t)t * D);
    float4 v[4]; float ss = 0.f;
#pragma unroll
    for (int i = 0; i < 4; ++i) { v[i] = xr[lane + 64 * i]; ss += v[i].x * v[i].x + v[i].y * v[i].y + v[i].z * v[i].z + v[i].w * v[i].w; }
    ss = wave_sum(ss);
    const float inv = rsqrtf(ss * (1.f / D) + 1e-5f);
    const int b = t / S;
    float4* ho = (float4*)(hout + (size_t)t * D);
#pragma unroll
    for (int i = 0; i < 4; ++i) {
      const int col = (lane + 64 * i) * 4;
      const float4 g4 = *(const float4*)(g + col), sc4 = *(const float4*)(sc + b * 6 * D + col), sh4 = *(const float4*)(sh + b * 6 * D + col);
      float4 o;
      o.x = v[i].x * inv * g4.x * (1.f + sc4.x) + sh4.x;
      o.y = v[i].y * inv * g4.y * (1.f + sc4.y) + sh4.y;
      o.z = v[i].z * inv * g4.z * (1.f + sc4.z) + sh4.z;
      o.w = v[i].w * inv * g4.w * (1.f + sc4.w) + sh4.w;
      ho[lane + 64 * i] = o;
    }
  }
}

template <int EPI, bool TRANSB>
__device__ void gemm_f32(const float* A, int lda, const float* W, int ldb, float* C, int ldc, int M, int N, int K, const float* gate, float* smem) {
  float (*As)[68] = (float (*)[68])smem;
  float (*Bs)[68] = (float (*)[68])(smem + 16 * 68);
  const int tilesN = (N + 63) / 64, tilesM = M / 64, ntiles = tilesN * tilesM;
  const int tid = threadIdx.x, tx = tid & 15, ty = tid >> 4;
  for (int tile = blockIdx.x; tile < ntiles; tile += gridDim.x) {
    const int tm = tile / tilesN, tn = tile % tilesN, m0 = tm * 64, n0 = tn * 64;
    float acc[4][4];
#pragma unroll
    for (int i = 0; i < 4; ++i)
#pragma unroll
      for (int j = 0; j < 4; ++j) acc[i][j] = 0.f;
    for (int k0 = 0; k0 < K; k0 += 16) {
      {
        const int row = tid >> 2, kq = (tid & 3) * 4;
        const float4 v = *(const float4*)(A + (size_t)(m0 + row) * lda + k0 + kq);
        As[kq + 0][row] = v.x; As[kq + 1][row] = v.y; As[kq + 2][row] = v.z; As[kq + 3][row] = v.w;
      }
      if (!TRANSB) {
        const int kk = tid >> 4, nq = (tid & 15) * 4;
        float4 v = make_float4(0.f, 0.f, 0.f, 0.f);
        if (n0 + nq < N) v = *(const float4*)(W + (size_t)(k0 + kk) * ldb + n0 + nq);
        *(float4*)&Bs[kk][nq] = v;
      } else {
        const int n = tid >> 2, kq = (tid & 3) * 4;
        float4 v = make_float4(0.f, 0.f, 0.f, 0.f);
        if (n0 + n < N) v = *(const float4*)(W + (size_t)(n0 + n) * ldb + k0 + kq);
        Bs[kq + 0][n] = v.x; Bs[kq + 1][n] = v.y; Bs[kq + 2][n] = v.z; Bs[kq + 3][n] = v.w;
      }
      __syncthreads();
#pragma unroll
      for (int k = 0; k < 16; ++k) {
        const float4 a = *(const float4*)&As[k][ty * 4];
        const float4 b = *(const float4*)&Bs[k][tx * 4];
        const float av[4] = {a.x, a.y, a.z, a.w}, bv[4] = {b.x, b.y, b.z, b.w};
#pragma unroll
        for (int i = 0; i < 4; ++i)
#pragma unroll
          for (int j = 0; j < 4; ++j) acc[i][j] += av[i] * bv[j];
      }
      __syncthreads();
    }
    const int n = n0 + tx * 4;
    if (n < N) {
#pragma unroll
      for (int i = 0; i < 4; ++i) {
        const int m = m0 + ty * 4 + i;
        float4* cp = (float4*)(C + (size_t)m * ldc + n);
        if (EPI == 0) {
          *cp = make_float4(acc[i][0], acc[i][1], acc[i][2], acc[i][3]);
        } else {
          const float4 gt = *(const float4*)(gate + (m / S) * 6 * D + n);
          float4 o = *cp;
          o.x += gt.x * acc[i][0]; o.y += gt.y * acc[i][1]; o.z += gt.z * acc[i][2]; o.w += gt.w * acc[i][3];
          *cp = o;
        }
      }
    }
  }
}

__device__ void phase_conv_dt_kmean(const Params& p, int l) {
  const int gtid = blockIdx.x * NTHR + threadIdx.x, gsz = gridDim.x * NTHR;
  const float* cw = p.conv_w + l * 4 * 1024; const float* cbv = p.conv_b + l * 1024;
  for (int idx = gtid; idx < T * 1024; idx += gsz) {
    const int t = idx >> 10, ch = idx & 1023, s = t & (S - 1);
    float acc = cbv[ch];
#pragma unroll
    for (int k = 0; k < 4; ++k) { const int sp = s - 3 + k; if (sp >= 0) acc += cw[k * 1024 + ch] * WSF(PROJ)[(size_t)(t - 3 + k) * NIN + C_XBC + ch]; }
    WSF(XBC)[idx] = siluf(acc);
  }
  for (int idx = gtid; idx < NB * 64 * 8; idx += gsz) {
    const int hh = idx & 7, bc = idx >> 3;
    const float ah = -expf(p.a_log[l * 8 + hh]), bias = p.dt_bias[l * 8 + hh];
    float run = 0.f;
    for (int li = 0; li < 128; ++li) {
      const int t = bc * 128 + li;
      const float v = WSF(PROJ)[(size_t)t * NIN + C_DT + hh] + bias;
      const float dt = v > 20.f ? v : log1pf(expf(v));
      run += dt * ah;
      WSF(DTB)[t * 8 + hh] = dt; WSF(ACS)[t * 8 + hh] = run;
    }
  }
  for (int idx = gtid; idx < NB * 4 * 32 * 64; idx += gsz) {
    const int d = idx & 63, n = (idx >> 6) & 31, hh = (idx >> 11) & 3, b = idx >> 13;
    float sum = 0.f;
    for (int j = 0; j < 256; ++j) sum += WSF(PROJ)[(size_t)(b * S + n * 256 + j) * NIN + C_MK + hh * 64 + d];
    WSF(KMEAN)[idx] = sum * (1.f / 256.f);
  }
}

__device__ void phase_cb(const Params& p) {
  const int gtid = blockIdx.x * NTHR + threadIdx.x, gsz = gridDim.x * NTHR;
  for (int idx = gtid; idx < NB * 64 * 2 * 128 * 128; idx += gsz) {
    const int s_ = idx & 127, l_ = (idx >> 7) & 127, g = (idx >> 14) & 1, bc = idx >> 15;
    if (s_ > l_) continue;
    const float4* cr = (const float4*)(WSF(XBC) + (size_t)(bc * 128 + l_) * 1024 + 768 + g * 128);
    const float4* br = (const float4*)(WSF(XBC) + (size_t)(bc * 128 + s_) * 1024 + 512 + g * 128);
    float acc = 0.f;
#pragma unroll 8
    for (int i = 0; i < 32; ++i) { const float4 a = cr[i], b = br[i]; acc += a.x * b.x + a.y * b.y + a.z * b.z + a.w * b.w; }
    WSF(CB)[idx] = acc;
  }
}

__device__ void phase_ssd_chunk(const Params& p, float* smem) {
  float (*xdt)[64] = (float (*)[64])smem;
  float* acs_s = smem + 128 * 64;
  const int tid = threadIdx.x, lane = tid & 63;
  for (int item = blockIdx.x; item < NB * 64 * 8; item += gridDim.x) {
    const int hh = item & 7, bc = item >> 3, g = hh >> 2, t0 = bc * 128;
    __syncthreads();
    for (int i = tid; i < 128 * 64; i += NTHR) {
      const int li = i >> 6, pp = i & 63;
      xdt[li][pp] = WSF(XBC)[(size_t)(t0 + li) * 1024 + hh * 64 + pp] * WSF(DTB)[(t0 + li) * 8 + hh];
    }
    if (tid < 128) acs_s[tid] = WSF(ACS)[(t0 + tid) * 8 + hh];
    __syncthreads();
    {
      const int pp = lane, lg = tid >> 6;
      const float* cbp = WSF(CB) + (size_t)(bc * 2 + g) * 128 * 128;
      for (int li = 0; li < 32; ++li) {
        const int l_ = lg + 4 * li;
        const float al = acs_s[l_];
        float acc = 0.f;
        for (int s0 = 0; s0 <= l_; s0 += 64) {
          const int sme = s0 + lane;
          float w = 0.f;
          if (sme <= l_) w = cbp[l_ * 128 + sme] * expf(al - acs_s[sme]);
          const int cnt = min(64, l_ - s0 + 1);
          for (int j = 0; j < cnt; ++j) acc += __shfl(w, j) * xdt[s0 + j][pp];
        }
        WSF(YBUF)[(size_t)(t0 + l_) * 512 + hh * 64 + pp] = acc;
      }
    }
    {
      const int n = tid & 127, pg = tid >> 7;
      float acc[32];
#pragma unroll
      for (int j = 0; j < 32; ++j) acc[j] = 0.f;
      const float alast = acs_s[127];
      for (int li = 0; li < 128; ++li) {
        const float bw = WSF(XBC)[(size_t)(t0 + li) * 1024 + 512 + g * 128 + n] * expf(alast - acs_s[li]);
#pragma unroll
        for (int j = 0; j < 32; ++j) acc[j] += bw * xdt[li][pg * 32 + j];
      }
      float* sp = WSF(STATES) + ((size_t)(bc * 8 + hh) * 64) * 128;
#pragma unroll
      for (int j = 0; j < 32; ++j) sp[(pg * 32 + j) * 128 + n] = acc[j];
    }
  }
  __syncthreads();
}

__device__ void phase_scan(const Params& p) {
  const int gtid = blockIdx.x * NTHR + threadIdx.x, gsz = gridDim.x * NTHR;
  for (int idx = gtid; idx < NB * 8 * 64 * 128; idx += gsz) {
    const int pn = idx & 8191, hh = (idx >> 13) & 7, b = idx >> 16;
    float Sv = 0.f;
    for (int c = 0; c < 64; ++c) {
      const size_t off = ((size_t)((b * 64 + c) * 8 + hh)) * 8192 + pn;
      const float tmp = WSF(STATES)[off];
      WSF(STATES)[off] = Sv;
      Sv = expf(WSF(ACS)[(b * S + c * 128 + 127) * 8 + hh]) * Sv + tmp;
    }
  }
}

__device__ void phase_ssd_off(const Params& p, int l, float* smem) {
  float (*Sin)[129] = (float (*)[129])smem;
  float* acs_s = smem + 64 * 129;
  const int tid = threadIdx.x, lane = tid & 63;
  for (int item = blockIdx.x; item < NB * 64 * 8; item += gridDim.x) {
    const int hh = item & 7, bc = item >> 3, g = hh >> 2, t0 = bc * 128;
    __syncthreads();
    const float* sp = WSF(STATES) + ((size_t)(bc * 8 + hh) * 64) * 128;
    for (int i = tid; i < 64 * 128; i += NTHR) Sin[i >> 7][i & 127] = sp[i];
    if (tid < 128) acs_s[tid] = WSF(ACS)[(t0 + tid) * 8 + hh];
    __syncthreads();
    const int pp = lane, lg = tid >> 6;
    const float dsk = p.d_skip[l * 8 + hh];
    for (int li = 0; li < 32; ++li) {
      const int l_ = lg + 4 * li;
      const float* cr = WSF(XBC) + (size_t)(t0 + l_) * 1024 + 768 + g * 128;
      float acc = 0.f;
#pragma unroll 8
      for (int n = 0; n < 128; ++n) acc += cr[n] * Sin[pp][n];
      const size_t yo = (size_t)(t0 + l_) * 512 + hh * 64 + pp;
      WSF(YBUF)[yo] = WSF(YBUF)[yo] + expf(acs_s[l_]) * acc + dsk * WSF(XBC)[(size_t)(t0 + l_) * 1024 + hh * 64 + pp];
    }
  }
  __syncthreads();
}

__device__ void phase_mix_norm(const Params& p, int l) {
  const int wave = (blockIdx.x * NTHR + threadIdx.x) >> 6, nw = gridDim.x * (NTHR / 64), lane = threadIdx.x & 63;
  for (int item = wave; item < T * 3; item += nw) {
    const int t = item / 3, part = item % 3;
    if (part == 0) {
      float4 v[2]; float ss = 0.f;
#pragma unroll
      for (int i = 0; i < 2; ++i) {
        const int col = (lane + 64 * i) * 4;
        const float4 y = *(const float4*)(WSF(YBUF) + (size_t)t * 512 + col);
        const float4 z = *(const float4*)(WSF(PROJ) + (size_t)t * NIN + C_Z + col);
        v[i].x = y.x * siluf(z.x); v[i].y = y.y * siluf(z.y); v[i].z = y.z * siluf(z.z); v[i].w = y.w * siluf(z.w);
        ss += v[i].x * v[i].x + v[i].y * v[i].y + v[i].z * v[i].z + v[i].w * v[i].w;
      }
      ss = wave_sum(ss);
      const float inv = rsqrtf(ss * (1.f / 512.f) + 1e-5f);
#pragma unroll
      for (int i = 0; i < 2; ++i) {
        const int col = (lane + 64 * i) * 4;
        const float4 g4 = *(const float4*)(p.ssd_norm_g + l * 512 + col);
        *(float4*)(WSF(YCAT) + (size_t)t * 1024 + col) = make_float4(v[i].x * inv * g4.x, v[i].y * inv * g4.y, v[i].z * inv * g4.z, v[i].w * inv * g4.w);
      }
    } else {
      const int col0 = part == 1 ? 512 : 768;
      const float* gp = part == 1 ? p.moba_norm_g + l * 256 : p.swa_norm_g + l * 256;
      float4* yp = (float4*)(WSF(YCAT) + (size_t)t * 1024 + col0 + lane * 4);
      const float4 v = *yp;
      float ss = wave_sum(v.x * v.x + v.y * v.y + v.z * v.z + v.w * v.w);
      const float inv = rsqrtf(ss * (1.f / 256.f) + 1e-5f);
      const float4 g4 = *(const float4*)(gp + lane * 4);
      *yp = make_float4(v.x * inv * g4.x, v.y * inv * g4.y, v.z * inv * g4.z, v.w * inv * g4.w);
    }
  }
}

__device__ void phase_moba(const Params& p) {
  const int gtid = blockIdx.x * NTHR + threadIdx.x, gsz = gridDim.x * NTHR;
  for (int idx = gtid; idx < T * 4; idx += gsz) {
    const int hh = idx / T, t = idx % T, b = t / S, s = t & (S - 1), blk = s >> 8;
    float4 q[16], o[16];
    const float4* qp = (const float4*)(WSF(PROJ) + (size_t)t * NIN + C_MQ + hh * 64);
#pragma unroll
    for (int i = 0; i < 16; ++i) { q[i] = qp[i]; o[i] = make_float4(0.f, 0.f, 0.f, 0.f); }
    float v0 = -INFINITY, v1 = -INFINITY, v2 = -INFINITY; int i0 = 0, i1 = 0, i2 = 0;
#pragma unroll 1
    for (int n = 0; n < blk; ++n) {
      const float4* kp = (const float4*)(WSF(KMEAN) + ((b * 4 + hh) * 32 + n) * 64);
      float gsc = 0.f;
#pragma unroll
      for (int i = 0; i < 16; ++i) { const float4 k = kp[i]; gsc += q[i].x * k.x + q[i].y * k.y + q[i].z * k.z + q[i].w * k.w; }
      if (gsc > v0) { v2 = v1; i2 = i1; v1 = v0; i1 = i0; v0 = gsc; i0 = n; }
      else if (gsc > v1) { v2 = v1; i2 = i1; v1 = gsc; i1 = n; }
      else if (gsc > v2) { v2 = gsc; i2 = n; }
    }
    const int nsel = blk < 3 ? blk : 3;
    float m = -INFINITY, lsum = 0.f;
    for (int j = 0; j <= nsel; ++j) {
      int kb, cnt;
      if (j < nsel) { kb = (j == 0 ? i0 : (j == 1 ? i1 : i2)); cnt = 256; }
      else { kb = blk; cnt = (s & 255) + 1; }
      const size_t row0 = (size_t)(b * S + kb * 256);
#pragma unroll 1
      for (int kk = 0; kk < cnt; ++kk) {
        const float4* kp = (const float4*)(WSF(PROJ) + (row0 + kk) * NIN + C_MK + hh * 64);
        float sc = 0.f;
#pragma unroll
        for (int i = 0; i < 16; ++i) { const float4 k = kp[i]; sc += q[i].x * k.x + q[i].y * k.y + q[i].z * k.z + q[i].w * k.w; }
        sc *= 0.125f;
        if (sc > m) {
          const float corr = expf(m - sc);
          lsum *= corr;
#pragma unroll
          for (int i = 0; i < 16; ++i) { o[i].x *= corr; o[i].y *= corr; o[i].z *= corr; o[i].w *= corr; }
          m = sc;
        }
        const float pe = expf(sc - m);
        lsum += pe;
        const float4* vp = (const float4*)(WSF(PROJ) + (row0 + kk) * NIN + C_MV + hh * 64);
#pragma unroll
        for (int i = 0; i < 16; ++i) { const float4 v = vp[i]; o[i].x += pe * v.x; o[i].y += pe * v.y; o[i].z += pe * v.z; o[i].w += pe * v.w; }
      }
    }
    const float inv = 1.f / lsum;
    float4* op = (float4*)(WSF(YCAT) + (size_t)t * 1024 + 512 + hh * 64);
#pragma unroll
    for (int i = 0; i < 16; ++i) op[i] = make_float4(o[i].x * inv, o[i].y * inv, o[i].z * inv, o[i].w * inv);
  }
}

__device__ void phase_swa(const Params& p, int l) {
  const int gtid = blockIdx.x * NTHR + threadIdx.x, gsz = gridDim.x * NTHR;
  for (int idx = gtid; idx < T * 4; idx += gsz) {
    const int hh = idx / T, t = idx % T, s = t & (S - 1), kvh = hh >> 1;
    float4 q[16], o[16];
    const float4* qp = (const float4*)(WSF(PROJ) + (size_t)t * NIN + C_SQ + hh * 64);
#pragma unroll
    for (int i = 0; i < 16; ++i) { q[i] = qp[i]; o[i] = make_float4(0.f, 0.f, 0.f, 0.f); }
    const float sink = p.swa_sinks[l * 4 + hh];
    float m = sink, lsum = 1.f;
    const int cnt = s < 127 ? s + 1 : 128;
    const size_t row0 = (size_t)(t - cnt + 1);
#pragma unroll 1
    for (int kk = 0; kk < cnt; ++kk) {
      const float4* kp = (const float4*)(WSF(PROJ) + (row0 + kk) * NIN + C_SK + kvh * 64);
      float sc = 0.f;
#pragma unroll
      for (int i = 0; i < 16; ++i) { const float4 k = kp[i]; sc += q[i].x * k.x + q[i].y * k.y + q[i].z * k.z + q[i].w * k.w; }
      sc *= 0.125f;
      if (sc > m) {
        const float corr = expf(m - sc);
        lsum *= corr;
#pragma unroll
        for (int i = 0; i < 16; ++i) { o[i].x *= corr; o[i].y *= corr; o[i].z *= corr; o[i].w *= corr; }
        m = sc;
      }
      const float pe = expf(sc - m);
      lsum += pe;
      const float4* vp = (const float4*)(WSF(PROJ) + (row0 + kk) * NIN + C_SV + kvh * 64);
#pragma unroll
      for (int i = 0; i < 16; ++i) { const float4 v = vp[i]; o[i].x += pe * v.x; o[i].y += pe * v.y; o[i].z += pe * v.z; o[i].w += pe * v.w; }
    }
    const float inv = 1.f / lsum;
    float4* op = (float4*)(WSF(YCAT) + (size_t)t * 1024 + 768 + hh * 64);
#pragma unroll
    for (int i = 0; i < 16; ++i) op[i] = make_float4(o[i].x * inv, o[i].y * inv, o[i].z * inv, o[i].w * inv);
  }
}

__device__ void phase_peer_topk(const Params& p) {
  const int wave = (blockIdx.x * NTHR + threadIdx.x) >> 6, nw = gridDim.x * (NTHR / 64), lane = threadIdx.x & 63;
  for (int row = wave; row < T * 8; row += nw) {
    float myv1 = 0.f, myv2 = 0.f; int myi1 = 0, myi2 = 0;
    {
      float a0 = WSF(S1)[(size_t)row * 128 + lane], a1 = WSF(S1)[(size_t)row * 128 + 64 + lane];
      for (int r = 0; r < 16; ++r) {
        float v; int i;
        if (a0 >= a1) { v = a0; i = lane; } else { v = a1; i = lane + 64; }
        wave_argmax(v, i);
        if (i == lane) a0 = -INFINITY; else if (i == lane + 64) a1 = -INFINITY;
        if (lane == r) { myv1 = v; myi1 = i; }
      }
    }
    {
      float a0 = WSF(S2)[(size_t)row * 128 + lane], a1 = WSF(S2)[(size_t)row * 128 + 64 + lane];
      for (int r = 0; r < 16; ++r) {
        float v; int i;
        if (a0 >= a1) { v = a0; i = lane; } else { v = a1; i = lane + 64; }
        wave_argmax(v, i);
        if (i == lane) a0 = -INFINITY; else if (i == lane + 64) a1 = -INFINITY;
        if (lane == r) { myv2 = v; myi2 = i; }
      }
    }
    float cd[4];
#pragma unroll
    for (int j = 0; j < 4; ++j) cd[j] = __shfl(myv1, (lane >> 4) + 4 * j) + __shfl(myv2, lane & 15);
    float scv = 0.f; int cidx = 0;
    for (int r = 0; r < 16; ++r) {
      float v = cd[0]; int i = lane;
#pragma unroll
      for (int j = 1; j < 4; ++j) if (cd[j] > v) { v = cd[j]; i = lane + 64 * j; }
      wave_argmax(v, i);
      if ((i & 63) == lane) {
        const int j = i >> 6;
        if (j == 0) cd[0] = -INFINITY; else if (j == 1) cd[1] = -INFINITY; else if (j == 2) cd[2] = -INFINITY; else cd[3] = -INFINITY;
      }
      if (lane == r) { scv = v; cidx = i; }
    }
    const int e1 = __shfl(myi1, (cidx >> 4) & 63), e2 = __shfl(myi2, cidx & 15);
    const float mx = __shfl(scv, 0);
    const float ex = lane < 16 ? expf(scv - mx) : 0.f;
    const float sum = wave_sum(ex);
    if (lane < 16) { WSI(EIDX)[(size_t)row * 16 + lane] = e1 * 128 + e2; WSF(GVAL)[(size_t)row * 16 + lane] = ex / sum; }
  }
}

__device__ void phase_peer_expert(const Params& p, int l) {
  const int wave = (blockIdx.x * NTHR + threadIdx.x) >> 6, nw = gridDim.x * (NTHR / 64), lane = threadIdx.x & 63;
  const float* U = p.peer_u + (size_t)l * 16384 * 1024; const float* V = p.peer_v + (size_t)l * 16384 * 1024;
  const float* g2 = WSF(MOD) + (size_t)l * 2 * 6 * D + 5 * D;
  for (int t = wave; t < T; t += nw) {
    const float4* hr = (const float4*)(WSF(H) + (size_t)t * D);
    float4 h4[4], acc[4];
#pragma unroll
    for (int i = 0; i < 4; ++i) { h4[i] = hr[lane + 64 * i]; acc[i] = make_float4(0.f, 0.f, 0.f, 0.f); }
    for (int p0 = 0; p0 < 128; p0 += 64) {
      const int my_e = WSI(EIDX)[(size_t)t * 128 + p0 + lane];
      const float my_g = WSF(GVAL)[(size_t)t * 128 + p0 + lane];
      for (int j = 0; j < 64; ++j) {
        const int e = __shfl(my_e, j); const float gg = __shfl(my_g, j);
        const float4* ur = (const float4*)(U + (size_t)e * 1024);
        float d = 0.f;
#pragma unroll
        for (int i = 0; i < 4; ++i) { const float4 u = ur[lane + 64 * i]; d += u.x * h4[i].x + u.y * h4[i].y + u.z * h4[i].z + u.w * h4[i].w; }
        d = wave_sum(d);
        const float act = 0.5f * d * (1.f + erff(d * 0.70710678118654752f)) * gg;
        const float4* vr = (const float4*)(V + (size_t)e * 1024);
#pragma unroll
        for (int i = 0; i < 4; ++i) { const float4 v = vr[lane + 64 * i]; acc[i].x += act * v.x; acc[i].y += act * v.y; acc[i].z += act * v.z; acc[i].w += act * v.w; }
      }
    }
    const int b = t / S;
    float4* xr = (float4*)(WSF(XCUR) + (size_t)t * D);
#pragma unroll
    for (int i = 0; i < 4; ++i) {
      const int col = (lane + 64 * i) * 4;
      const float4 gt = *(const float4*)(g2 + b * 6 * D + col);
      float4 xv = xr[lane + 64 * i];
      xv.x += gt.x * acc[i].x; xv.y += gt.y * acc[i].y; xv.z += gt.z * acc[i].z; xv.w += gt.w * acc[i].w;
      xr[lane + 64 * i] = xv;
    }
  }
}

__device__ void phase_final(const Params& p) {
  const int wave = (blockIdx.x * NTHR + threadIdx.x) >> 6, nw = gridDim.x * (NTHR / 64), lane = threadIdx.x & 63;
  for (int t = wave; t < T; t += nw) {
    const float4* xr = (const float4*)(WSF(XCUR) + (size_t)t * D);
    float4 v[4]; float ss = 0.f;
#pragma unroll
    for (int i = 0; i < 4; ++i) { v[i] = xr[lane + 64 * i]; ss += v[i].x * v[i].x + v[i].y * v[i].y + v[i].z * v[i].z + v[i].w * v[i].w; }
    ss = wave_sum(ss);
    const float inv = rsqrtf(ss * (1.f / D) + 1e-5f);
    float4* orow = (float4*)(p.out + (size_t)t * D);
#pragma unroll
    for (int i = 0; i < 4; ++i) {
      const float4 g4 = *(const float4*)(p.final_g + (lane + 64 * i) * 4);
      orow[lane + 64 * i] = make_float4(v[i].x * inv * g4.x, v[i].y * inv * g4.y, v[i].z * inv * g4.z, v[i].w * inv * g4.w);
    }
  }
}

__device__ __forceinline__ void gsync(cg::grid_group& g) {
  asm volatile("s_waitcnt vmcnt(0)" ::: "memory");
  __syncthreads();
  g.sync();
  __builtin_amdgcn_fence(__ATOMIC_ACQUIRE, "agent");
  asm volatile("s_waitcnt vmcnt(0)" ::: "memory");
}

__global__ void __launch_bounds__(NTHR) hymba_fwd(Params p) {
  cg::grid_group grid = cg::this_grid();
  __shared__ __attribute__((aligned(16))) float smem[9216];
  phase_mod(p, smem);
  gsync(grid);
#pragma unroll 1
  for (int l = 0; l < NL; ++l) {
    const float* modl = WSF(MOD) + (size_t)l * 2 * 6 * D;
    phase_norm_mod(WSF(XCUR), p.norm1_g + l * D, modl + 1 * D, modl + 0 * D, WSF(H));
    gsync(grid);
    gemm_f32<0, false>(WSF(H), D, p.w_in + (size_t)l * D * NIN, NIN, WSF(PROJ), NIN, T, NIN, D, nullptr, smem);
    gsync(grid);
    phase_conv_dt_kmean(p, l);
    gsync(grid);
    phase_cb(p);
    phase_swa(p, l);
    gsync(grid);
    phase_ssd_chunk(p, smem);
    phase_moba(p);
    gsync(grid);
    phase_scan(p);
    gsync(grid);
    phase_ssd_off(p, l, smem);
    gsync(grid);
    phase_mix_norm(p, l);
    gsync(grid);
    gemm_f32<1, false>(WSF(YCAT), D, p.w_out + (size_t)l * D * D, D, WSF(XCUR), D, T, D, D, modl + 2 * D, smem);
    gsync(grid);
    phase_norm_mod(WSF(XCUR), p.norm2_g + l * D, modl + 4 * D, modl + 3 * D, WSF(H));
    gsync(grid);
    gemm_f32<0, false>(WSF(H), D, p.peer_wq + (size_t)l * D * 2048, 2048, WSF(QBUF), 2048, T, 2048, D, nullptr, smem);
    gsync(grid);
    gemm_f32<0, true>(WSF(QBUF), 256, p.peer_k1 + (size_t)l * 128 * 128, 128, WSF(S1), 128, T * 8, 128, 128, nullptr, smem);
    gemm_f32<0, true>(WSF(QBUF) + 128, 256, p.peer_k2 + (size_t)l * 128 * 128, 128, WSF(S2), 128, T * 8, 128, 128, nullptr, smem);
    gsync(grid);
    phase_peer_topk(p);
    gsync(grid);
    phase_peer_expert(p, l);
    gsync(grid);
  }
  phase_final(p);
}

extern "C" void kernel_launch(void* const* d_in, const int* in_sizes, int n_in, void* d_out, int out_size, void* d_ws, size_t ws_size, hipStream_t stream) {
  static int grid_blocks = 0;
  if (!grid_blocks) {
    int dev = 0, cus = 0, per_cu = 0;
    hipGetDevice(&dev);
    hipDeviceGetAttribute(&cus, hipDeviceAttributeMultiprocessorCount, dev);
    hipOccupancyMaxActiveBlocksPerMultiprocessor(&per_cu, hymba_fwd, NTHR, 0);
    if (per_cu > 4) per_cu = 4;
    if (per_cu < 1) per_cu = 1;
    grid_blocks = cus * per_cu;
  }
  Params p;
  memset(&p, 0, sizeof(p));
  const float** ins = (const float**)&p;
  for (int i = 0; i < 23; ++i) ins[i] = (const float*)d_in[i];
  p.out = (float*)d_out;
  p.ws = (char*)d_ws;
  if (ws_size < WS_TOTAL) fprintf(stderr, "workspace too small: %zu < %zu\n", ws_size, WS_TOTAL);
  void* args[] = {&p};
  hipError_t e = hipLaunchCooperativeKernel((void*)hymba_fwd, dim3(grid_blocks), dim3(NTHR), args, 0, stream);
  if (e != hipSuccess) fprintf(stderr, "cooperative launch failed: %s (grid %d)\n", hipGetErrorString(e), grid_blocks);
}
```

```cpp
#include <hip/hip_runtime.h>
#include <hip/hip_cooperative_groups.h>
#include <cstdio>
#include <cstdint>
#include <cstring>
namespace cg = cooperative_groups;

constexpr int D = 1024, NB = 2, S = 8192, T = NB * S, NL = 4;
constexpr int NIN = 2824;
constexpr int C_Z = 0, C_XBC = 512, C_DT = 1536, C_MQ = 1544, C_MK = 1800, C_MV = 2056, C_SQ = 2312, C_SK = 2568, C_SV = 2696;
constexpr int NTHR = 256;

struct Params {
  const float *x, *c, *ada_w, *ada_b, *norm1_g, *norm2_g, *w_in, *conv_w, *conv_b, *dt_bias, *a_log, *d_skip,
      *ssd_norm_g, *moba_norm_g, *swa_sinks, *swa_norm_g, *w_out, *peer_wq, *peer_k1, *peer_k2, *peer_u, *peer_v, *final_g;
  float* out;
  char* ws;
};
constexpr size_t al256(size_t x) { return (x + 255) & ~(size_t)255; }
constexpr size_t OFF_MOD = 0;
constexpr size_t OFF_KMEAN = OFF_MOD + al256((size_t)NL * 2 * 6 * D * 4);
constexpr size_t OFF_XCUR = OFF_KMEAN + al256((size_t)NB * 4 * 32 * 64 * 4);
constexpr size_t OFF_H = OFF_XCUR + al256((size_t)T * D * 4);
constexpr size_t OFF_PROJ = OFF_H + al256((size_t)T * D * 4);
constexpr size_t OFF_XBC = OFF_PROJ + al256((size_t)T * NIN * 4);
constexpr size_t OFF_DTB = OFF_XBC + al256((size_t)T * 1024 * 4);
constexpr size_t OFF_ACS = OFF_DTB + al256((size_t)T * 8 * 4);
constexpr size_t OFF_CB = OFF_ACS + al256((size_t)T * 8 * 4);
constexpr size_t OFF_YBUF = OFF_CB + al256((size_t)NB * 64 * 2 * 128 * 128 * 4);
constexpr size_t OFF_STATES = OFF_YBUF + al256((size_t)T * 512 * 4);
constexpr size_t OFF_YCAT = OFF_STATES + al256((size_t)NB * 64 * 8 * 64 * 128 * 4);
constexpr size_t OFF_EIDX = OFF_YCAT + al256((size_t)T * 1024 * 4);
constexpr size_t OFF_GVAL = OFF_EIDX + al256((size_t)T * 128 * 4);
constexpr int NINP = 2944;
constexpr size_t OFF_HB = OFF_GVAL + al256((size_t)T * 128 * 4);
constexpr size_t OFF_YCATB = OFF_HB + al256((size_t)T * D * 2);
constexpr size_t OFF_WINT = OFF_YCATB + al256((size_t)T * D * 2);
constexpr size_t OFF_WOUTT = OFF_WINT + al256((size_t)NL * NINP * D * 2);
constexpr size_t OFF_WQT = OFF_WOUTT + al256((size_t)NL * D * D * 2);
constexpr size_t OFF_UB = OFF_WQT + al256((size_t)NL * 2048 * D * 2);
constexpr size_t OFF_VB = OFF_UB + al256((size_t)NL * 16384 * D * 2);
constexpr size_t OFF_K12B = OFF_VB + al256((size_t)NL * 16384 * D * 2);
constexpr size_t WS_TOTAL = OFF_K12B + al256((size_t)NL * 2 * 128 * 128 * 2);
constexpr size_t OFF_MQK = WS_TOTAL;
constexpr size_t OFF_MVT = OFF_MQK + al256((size_t)T * 512 * 2);
constexpr size_t OFF_SQK = OFF_MVT + al256((size_t)T * 256 * 2);
constexpr size_t OFF_SVT = OFF_SQK + al256((size_t)T * 384 * 2);
constexpr size_t OFF_MSEL = OFF_SVT + al256((size_t)T * 128 * 2);
constexpr size_t WS_TOTAL2 = OFF_MSEL + al256((size_t)T * 4 * 4);
constexpr size_t OFF_QB = OFF_PROJ;
constexpr size_t OFF_QBUF = OFF_PROJ;
constexpr size_t OFF_S1 = OFF_XBC;
constexpr size_t OFF_S2 = OFF_YCAT;
#define WSF(name) ((float*)(p.ws + OFF_##name))
#define WSI(name) ((int*)(p.ws + OFF_##name))
#define WSH(name) ((bf16_t*)(p.ws + OFF_##name))
typedef unsigned short bf16_t;
typedef short bf16x8 __attribute__((ext_vector_type(8)));
typedef float f32x4 __attribute__((ext_vector_type(4)));
typedef float f32x16 __attribute__((ext_vector_type(16)));
__device__ __forceinline__ bf16_t f2bf(float f) { unsigned u = __float_as_uint(f); u += 0x7fffu + ((u >> 16) & 1u); return (bf16_t)(u >> 16); }
__device__ __forceinline__ unsigned pack2bf(float lo, float hi) { return (unsigned)f2bf(lo) | ((unsigned)f2bf(hi) << 16); }
__device__ __forceinline__ float bflo(unsigned w) { return __uint_as_float(w << 16); }
__device__ __forceinline__ float bfhi(unsigned w) { return __uint_as_float(w & 0xffff0000u); }

__device__ __forceinline__ int opaque_tid() { int t = threadIdx.x; asm volatile("" : "+v"(t)); return t; }
#define TIDX opaque_tid()
__device__ __forceinline__ float siluf(float x) { return x / (1.f + expf(-x)); }
__device__ __forceinline__ float wave_sum(float v) {
#pragma unroll
  for (int o = 32; o > 0; o >>= 1) v += __shfl_xor(v, o);
  return v;
}
__device__ __forceinline__ void wave_argmax(float& v, int& i) {
#pragma unroll
  for (int o = 32; o > 0; o >>= 1) {
    float ov = __shfl_xor(v, o);
    int oi = __shfl_xor(i, o);
    if (ov > v || (ov == v && oi < i)) { v = ov; i = oi; }
  }
}

__device__ void phase_mod(const Params& p, float* smem) {
  for (int i = TIDX; i < NB * D; i += NTHR) smem[i] = siluf(p.c[i]);
  __syncthreads();
  const int gtid = blockIdx.x * NTHR + TIDX, gsz = gridDim.x * NTHR;
  {
    float* red = smem + 2 * D;
    const int jl = TIDX & 63, ks = TIDX >> 6;
    for (int cb = blockIdx.x; cb < NL * 6 * D / 64; cb += gridDim.x) {
      const int idx = cb * 64 + jl, l = idx / (6 * D), j = idx % (6 * D);
      const float* w = p.ada_w + (size_t)l * D * 6 * D + j + (size_t)(ks * 256) * 6 * D;
      float a0 = 0.f, a1 = 0.f;
#pragma unroll 16
      for (int k = 0; k < 256; ++k) { const float wv = w[(size_t)k * 6 * D]; a0 += smem[ks * 256 + k] * wv; a1 += smem[D + ks * 256 + k] * wv; }
      __syncthreads();
      red[(ks * 64 + jl) * 2] = a0; red[(ks * 64 + jl) * 2 + 1] = a1;
      __syncthreads();
      if (ks == 0) {
        const float bb = p.ada_b[l * 6 * D + j];
        WSF(MOD)[(l * 2 + 0) * 6 * D + j] = red[jl * 2] + red[(64 + jl) * 2] + red[(128 + jl) * 2] + red[(192 + jl) * 2] + bb;
        WSF(MOD)[(l * 2 + 1) * 6 * D + j] = red[jl * 2 + 1] + red[(64 + jl) * 2 + 1] + red[(128 + jl) * 2 + 1] + red[(192 + jl) * 2 + 1] + bb;
      }
    }
  }
  const float4* xs = (const float4*)p.x; float4* xd = (float4*)WSF(XCUR);
  for (int i = gtid; i < T * D / 4; i += gsz) xd[i] = xs[i];
  __syncthreads();
}

__device__ void phase_norm_mod(const float* xin, const float* g, const float* sc, const float* sh, float* hout, bf16_t* hb) {
  const int wave = (blockIdx.x * NTHR + TIDX) >> 6, nw = gridDim.x * (NTHR / 64), lane = TIDX & 63;
  for (int t = wave; t < T; t += nw) {
    const float4* xr = (const float4*)(xin + (size_t)t * D);
    float4 v[4]; float ss = 0.f;
#pragma unroll
    for (int i = 0; i < 4; ++i) { v[i] = xr[lane + 64 * i]; ss += v[i].x * v[i].x + v[i].y * v[i].y + v[i].z * v[i].z + v[i].w * v[i].w; }
    ss = wave_sum(ss);
    const float inv = rsqrtf(ss * (1.f / D) + 1e-5f);
    const int b = t / S;
    float4* ho = (float4*)(hout + (size_t)t * D);
#pragma unroll
    for (int i = 0; i < 4; ++i) {
      const int col = (lane + 64 * i) * 4;
      const float4 g4 = *(const float4*)(g + col), sc4 = *(const float4*)(sc + b * 6 * D + col), sh4 = *(const float4*)(sh + b * 6 * D + col);
      float4 o;
      o.x = v[i].x * inv * g4.x * (1.f + sc4.x) + sh4.x;
      o.y = v[i].y * inv * g4.y * (1.f + sc4.y) + sh4.y;
      o.z = v[i].z * inv * g4.z * (1.f + sc4.z) + sh4.z;
      o.w = v[i].w * inv * g4.w * (1.f + sc4.w) + sh4.w;
      ho[lane + 64 * i] = o;
      *(uint2*)(hb + (size_t)t * D + col) = make_uint2(pack2bf(o.x, o.y), pack2bf(o.z, o.w));
    }
  }
}

__device__ void transpose_cvt(const float* __restrict__ W, int K, int N, int Npad, bf16_t* __restrict__ Bt, float* smem) {
  float (*tile)[65] = (float (*)[65])smem;
  const int tk = K / 64, tn = Npad / 64, tid = TIDX;
  for (int t = blockIdx.x; t < tk * tn; t += gridDim.x) {
    const int k0 = (t / tn) * 64, n0 = (t % tn) * 64;
    __syncthreads();
#pragma unroll
    for (int r = 0; r < 16; ++r) {
      const int k = r * 4 + (tid >> 6), n = tid & 63;
      tile[k][n] = (n0 + n < N) ? W[(size_t)(k0 + k) * N + n0 + n] : 0.f;
    }
    __syncthreads();
#pragma unroll
    for (int r = 0; r < 16; ++r) {
      const int n = r * 4 + (tid >> 6), k = tid & 63;
      Bt[(size_t)(n0 + n) * K + k0 + k] = f2bf(tile[k][n]);
    }
  }
  __syncthreads();
}
__device__ void phase_prologue_weights(const Params& p, float* smem) {
  for (int l = 0; l < NL; ++l) {
    transpose_cvt(p.w_in + (size_t)l * D * NIN, D, NIN, NINP, WSH(WINT) + (size_t)l * NINP * D, smem);
    transpose_cvt(p.w_out + (size_t)l * D * D, D, D, D, WSH(WOUTT) + (size_t)l * D * D, smem);
    transpose_cvt(p.peer_wq + (size_t)l * D * 2048, D, 2048, 2048, WSH(WQT) + (size_t)l * 2048 * D, smem);
  }
  const int gtid = blockIdx.x * NTHR + TIDX, gsz = gridDim.x * NTHR;
  for (int i = gtid; i < NL * 2 * 128 * 128; i += gsz) {
    const int l = i / 32768, r = i % 32768;
    WSH(K12B)[i] = f2bf(r < 16384 ? p.peer_k1[l * 16384 + r] : p.peer_k2[l * 16384 + r - 16384]);
  }
  const size_t n8 = (size_t)NL * 16384 * D / 8;
  for (int which = 0; which < 2; ++which) {
    const float4* src = (const float4*)(which ? p.peer_v : p.peer_u);
    uint4* dst = (uint4*)(p.ws + (which ? OFF_VB : OFF_UB));
    for (size_t i = gtid; i < n8; i += gsz) {
      const float4 a = src[2 * i], b = src[2 * i + 1];
      dst[i] = make_uint4(pack2bf(a.x, a.y), pack2bf(a.z, a.w), pack2bf(b.x, b.y), pack2bf(b.z, b.w));
    }
  }
}

struct EpiStoreF32 {
  float* C; int ldc, N;
  __device__ __forceinline__ void operator()(int m, int n, f32x4 v) const { if (n < N) *(f32x4*)(C + (size_t)m * ldc + n) = v; }
};
struct EpiInProj {
  float* C; bf16_t *mqk, *mvt, *sqk, *svt;
  __device__ __forceinline__ void operator()(int m, int n, f32x4 v) const {
    if (n >= NIN) return;
    *(f32x4*)(C + (size_t)m * NIN + n) = v;
    if (n < C_MQ) return;
    const int b = m / S, s = m & (S - 1);
    if (n < C_MV) { *(uint2*)(mqk + (size_t)m * 512 + (n - C_MQ)) = make_uint2(pack2bf(v[0], v[1]), pack2bf(v[2], v[3])); }
    else if (n < C_SQ) { bf16_t* q = mvt + ((size_t)(b * 256 + (n - C_MV))) * S + s; q[0] = f2bf(v[0]); q[S] = f2bf(v[1]); q[2 * S] = f2bf(v[2]); q[3 * S] = f2bf(v[3]); }
    else if (n < C_SV) { *(uint2*)(sqk + (size_t)m * 384 + (n - C_SQ)) = make_uint2(pack2bf(v[0], v[1]), pack2bf(v[2], v[3])); }
    else { bf16_t* q = svt + ((size_t)(b * 128 + (n - C_SV))) * S + s; q[0] = f2bf(v[0]); q[S] = f2bf(v[1]); q[2 * S] = f2bf(v[2]); q[3 * S] = f2bf(v[3]); }
  }
};
struct EpiStoreBf16 {
  bf16_t* C; int ldc;
  __device__ __forceinline__ void operator()(int m, int n, f32x4 v) const { *(uint2*)(C + (size_t)m * ldc + n) = make_uint2(pack2bf(v[0], v[1]), pack2bf(v[2], v[3])); }
};
struct EpiResid {
  float* X; const float* gate;
  __device__ __forceinline__ void operator()(int m, int n, f32x4 v) const {
    const f32x4 g = *(const f32x4*)(gate + (m / S) * 6 * D + n);
    f32x4* xp = (f32x4*)(X + (size_t)m * D + n);
    f32x4 o = *xp; o += g * v; *xp = o;
  }
};
template <class Epi>
__device__ void gemm_bf16(const bf16_t* __restrict__ A, int lda, const bf16_t* __restrict__ Bt, int ldb, int M, int Npad, int K, const Epi epi, char* smem) {
  const int tid = TIDX, lane = tid & 63, wid = tid >> 6, wr = wid >> 1, wc = wid & 1;
  const int tilesN = Npad / 128, tilesM = M / 128, ntiles = tilesM * tilesN, nk = K / 64;
  const int srow = tid >> 3, sch = tid & 7;
  const int swr = srow * 128 + ((sch ^ (srow & 7)) << 4);
  const int fa0 = (wr * 64 + (lane & 15)) * 128 + ((((lane >> 4)) ^ (lane & 7)) << 4);
  const int fb0 = (wc * 64 + (lane & 15)) * 128 + ((((lane >> 4)) ^ (lane & 7)) << 4);
  for (int tile = blockIdx.x; tile < ntiles; tile += gridDim.x) {
    const int tm = tile / tilesN, tn = tile % tilesN;
    const bf16_t* Ag = A + (size_t)(tm * 128 + srow) * lda + sch * 8;
    const bf16_t* Bg = Bt + (size_t)(tn * 128 + srow) * ldb + sch * 8;
    f32x4 acc[4][4];
#pragma unroll
    for (int i = 0; i < 4; ++i)
#pragma unroll
      for (int j = 0; j < 4; ++j) acc[i][j] = (f32x4){0.f, 0.f, 0.f, 0.f};
    uint4 ra0, ra1, ra2, ra3, rb0, rb1, rb2, rb3;
#define GLD(koff) do { \
      ra0 = *(const uint4*)(Ag + (koff)); ra1 = *(const uint4*)(Ag + (size_t)32 * lda + (koff)); ra2 = *(const uint4*)(Ag + (size_t)64 * lda + (koff)); ra3 = *(const uint4*)(Ag + (size_t)96 * lda + (koff)); \
      rb0 = *(const uint4*)(Bg + (koff)); rb1 = *(const uint4*)(Bg + (size_t)32 * ldb + (koff)); rb2 = *(const uint4*)(Bg + (size_t)64 * ldb + (koff)); rb3 = *(const uint4*)(Bg + (size_t)96 * ldb + (koff)); } while (0)
#define LST(base) do { \
      *(uint4*)(smem + (base) + swr) = ra0; *(uint4*)(smem + (base) + swr + 4096) = ra1; *(uint4*)(smem + (base) + swr + 8192) = ra2; *(uint4*)(smem + (base) + swr + 12288) = ra3; \
      *(uint4*)(smem + (base) + 16384 + swr) = rb0; *(uint4*)(smem + (base) + 16384 + swr + 4096) = rb1; *(uint4*)(smem + (base) + 16384 + swr + 8192) = rb2; *(uint4*)(smem + (base) + 16384 + swr + 12288) = rb3; } while (0)
    GLD(0);
    __syncthreads();
    LST(0);
    __syncthreads();
    for (int kt = 0; kt < nk; ++kt) {
      const int cur = (kt & 1) * 32768, nxt = 32768 - cur;
      if (kt + 1 < nk) GLD((kt + 1) * 64);
#pragma unroll
      for (int kk = 0; kk < 2; ++kk) {
        bf16x8 af0, af1, af2, af3, bf0, bf1, bf2, bf3;
        af0 = *(const bf16x8*)(smem + cur + ((fa0) ^ (kk * 64)));
        af1 = *(const bf16x8*)(smem + cur + ((fa0 + 2048) ^ (kk * 64)));
        af2 = *(const bf16x8*)(smem + cur + ((fa0 + 4096) ^ (kk * 64)));
        af3 = *(const bf16x8*)(smem + cur + ((fa0 + 6144) ^ (kk * 64)));
        bf0 = *(const bf16x8*)(smem + cur + 16384 + ((fb0) ^ (kk * 64)));
        bf1 = *(const bf16x8*)(smem + cur + 16384 + ((fb0 + 2048) ^ (kk * 64)));
        bf2 = *(const bf16x8*)(smem + cur + 16384 + ((fb0 + 4096) ^ (kk * 64)));
        bf3 = *(const bf16x8*)(smem + cur + 16384 + ((fb0 + 6144) ^ (kk * 64)));
#define MM(mi, ni, a, b) acc[mi][ni] = __builtin_amdgcn_mfma_f32_16x16x32_bf16(b, a, acc[mi][ni], 0, 0, 0)
        MM(0, 0, af0, bf0); MM(0, 1, af0, bf1); MM(0, 2, af0, bf2); MM(0, 3, af0, bf3);
        MM(1, 0, af1, bf0); MM(1, 1, af1, bf1); MM(1, 2, af1, bf2); MM(1, 3, af1, bf3);
        MM(2, 0, af2, bf0); MM(2, 1, af2, bf1); MM(2, 2, af2, bf2); MM(2, 3, af2, bf3);
        MM(3, 0, af3, bf0); MM(3, 1, af3, bf1); MM(3, 2, af3, bf2); MM(3, 3, af3, bf3);
#undef MM
      }
      if (kt + 1 < nk) LST(nxt);
      __syncthreads();
    }
#undef GLD
#undef LST
#pragma unroll
    for (int mi = 0; mi < 4; ++mi)
#pragma unroll
      for (int ni = 0; ni < 4; ++ni)
        epi(tm * 128 + wr * 64 + mi * 16 + (lane & 15), tn * 128 + wc * 64 + ni * 16 + (lane >> 4) * 4, acc[mi][ni]);
  }
}

template <int EPI, bool TRANSB>
__device__ void gemm_f32(const float* A, int lda, const float* W, int ldb, float* C, int ldc, int M, int N, int K, const float* gate, float* smem) {
  float (*As)[68] = (float (*)[68])smem;
  float (*Bs)[68] = (float (*)[68])(smem + 16 * 68);
  const int tilesN = (N + 63) / 64, tilesM = M / 64, ntiles = tilesN * tilesM;
  const int tid = TIDX, tx = tid & 15, ty = tid >> 4;
  for (int tile = blockIdx.x; tile < ntiles; tile += gridDim.x) {
    const int tm = tile / tilesN, tn = tile % tilesN, m0 = tm * 64, n0 = tn * 64;
    float acc[4][4];
#pragma unroll
    for (int i = 0; i < 4; ++i)
#pragma unroll
      for (int j = 0; j < 4; ++j) acc[i][j] = 0.f;
    for (int k0 = 0; k0 < K; k0 += 16) {
      {
        const int row = tid >> 2, kq = (tid & 3) * 4;
        const float4 v = *(const float4*)(A + (size_t)(m0 + row) * lda + k0 + kq);
        As[kq + 0][row] = v.x; As[kq + 1][row] = v.y; As[kq + 2][row] = v.z; As[kq + 3][row] = v.w;
      }
      if (!TRANSB) {
        const int kk = tid >> 4, nq = (tid & 15) * 4;
        float4 v = make_float4(0.f, 0.f, 0.f, 0.f);
        if (n0 + nq < N) v = *(const float4*)(W + (size_t)(k0 + kk) * ldb + n0 + nq);
        *(float4*)&Bs[kk][nq] = v;
      } else {
        const int n = tid >> 2, kq = (tid & 3) * 4;
        float4 v = make_float4(0.f, 0.f, 0.f, 0.f);
        if (n0 + n < N) v = *(const float4*)(W + (size_t)(n0 + n) * ldb + k0 + kq);
        Bs[kq + 0][n] = v.x; Bs[kq + 1][n] = v.y; Bs[kq + 2][n] = v.z; Bs[kq + 3][n] = v.w;
      }
      __syncthreads();
#pragma unroll
      for (int k = 0; k < 16; ++k) {
        const float4 a = *(const float4*)&As[k][ty * 4];
        const float4 b = *(const float4*)&Bs[k][tx * 4];
        const float av[4] = {a.x, a.y, a.z, a.w}, bv[4] = {b.x, b.y, b.z, b.w};
#pragma unroll
        for (int i = 0; i < 4; ++i)
#pragma unroll
          for (int j = 0; j < 4; ++j) acc[i][j] += av[i] * bv[j];
      }
      __syncthreads();
    }
    const int n = n0 + tx * 4;
    if (n < N) {
#pragma unroll
      for (int i = 0; i < 4; ++i) {
        const int m = m0 + ty * 4 + i;
        float4* cp = (float4*)(C + (size_t)m * ldc + n);
        if (EPI == 0) {
          *cp = make_float4(acc[i][0], acc[i][1], acc[i][2], acc[i][3]);
        } else {
          const float4 gt = *(const float4*)(gate + (m / S) * 6 * D + n);
          float4 o = *cp;
          o.x += gt.x * acc[i][0]; o.y += gt.y * acc[i][1]; o.z += gt.z * acc[i][2]; o.w += gt.w * acc[i][3];
          *cp = o;
        }
      }
    }
  }
}

__device__ void phase_conv_dt_kmean(const Params& p, int l) {
  const int gtid = blockIdx.x * NTHR + TIDX, gsz = gridDim.x * NTHR;
  const float* cw = p.conv_w + l * 4 * 1024; const float* cbv = p.conv_b + l * 1024;
  for (int idx = gtid; idx < T * 1024; idx += gsz) {
    const int t = idx >> 10, ch = idx & 1023, s = t & (S - 1);
    float acc = cbv[ch];
#pragma unroll
    for (int k = 0; k < 4; ++k) { const int sp = s - 3 + k; if (sp >= 0) acc += cw[k * 1024 + ch] * WSF(PROJ)[(size_t)(t - 3 + k) * NIN + C_XBC + ch]; }
    WSF(XBC)[idx] = siluf(acc);
  }
  for (int idx = gtid; idx < NB * 64 * 8; idx += gsz) {
    const int hh = idx & 7, bc = idx >> 3;
    const float ah = -expf(p.a_log[l * 8 + hh]), bias = p.dt_bias[l * 8 + hh];
    float run = 0.f;
    for (int li = 0; li < 128; ++li) {
      const int t = bc * 128 + li;
      const float v = WSF(PROJ)[(size_t)t * NIN + C_DT + hh] + bias;
      const float dt = v > 20.f ? v : log1pf(expf(v));
      run += dt * ah;
      WSF(DTB)[t * 8 + hh] = dt; WSF(ACS)[t * 8 + hh] = run;
    }
  }
  for (int idx = gtid; idx < NB * 4 * 32 * 64; idx += gsz) {
    const int d = idx & 63, n = (idx >> 6) & 31, hh = (idx >> 11) & 3, b = idx >> 13;
    float sum = 0.f;
    for (int j = 0; j < 256; ++j) sum += WSF(PROJ)[(size_t)(b * S + n * 256 + j) * NIN + C_MK + hh * 64 + d];
    WSF(KMEAN)[idx] = sum * (1.f / 256.f);
  }
}

__device__ void phase_cb(const Params& p) {
  const int gtid = blockIdx.x * NTHR + TIDX, gsz = gridDim.x * NTHR;
  for (int idx = gtid; idx < NB * 64 * 2 * 128 * 128; idx += gsz) {
    const int s_ = idx & 127, l_ = (idx >> 7) & 127, g = (idx >> 14) & 1, bc = idx >> 15;
    if (s_ > l_) continue;
    const float4* cr = (const float4*)(WSF(XBC) + (size_t)(bc * 128 + l_) * 1024 + 768 + g * 128);
    const float4* br = (const float4*)(WSF(XBC) + (size_t)(bc * 128 + s_) * 1024 + 512 + g * 128);
    float acc = 0.f;
#pragma unroll 8
    for (int i = 0; i < 32; ++i) { const float4 a = cr[i], b = br[i]; acc += a.x * b.x + a.y * b.y + a.z * b.z + a.w * b.w; }
    WSF(CB)[idx] = acc;
  }
}

__device__ void phase_ssd_chunk(const Params& p, float* smem) {
  float (*xdt)[64] = (float (*)[64])smem;
  float* acs_s = smem + 128 * 64;
  const int tid = TIDX, lane = tid & 63;
  for (int item = blockIdx.x; item < NB * 64 * 8; item += gridDim.x) {
    const int hh = item & 7, bc = item >> 3, g = hh >> 2, t0 = bc * 128;
    __syncthreads();
    for (int i = tid; i < 128 * 64; i += NTHR) {
      const int li = i >> 6, pp = i & 63;
      xdt[li][pp] = WSF(XBC)[(size_t)(t0 + li) * 1024 + hh * 64 + pp] * WSF(DTB)[(t0 + li) * 8 + hh];
    }
    if (tid < 128) acs_s[tid] = WSF(ACS)[(t0 + tid) * 8 + hh];
    __syncthreads();
    {
      const int pp = lane, lg = tid >> 6;
      const float* cbp = WSF(CB) + (size_t)(bc * 2 + g) * 128 * 128;
      for (int li = 0; li < 32; ++li) {
        const int l_ = lg + 4 * li;
        const float al = acs_s[l_];
        float acc = 0.f;
        for (int s0 = 0; s0 <= l_; s0 += 64) {
          const int sme = s0 + lane;
          float w = 0.f;
          if (sme <= l_) w = cbp[l_ * 128 + sme] * expf(al - acs_s[sme]);
          const int cnt = min(64, l_ - s0 + 1);
          for (int j = 0; j < cnt; ++j) acc += __shfl(w, j) * xdt[s0 + j][pp];
        }
        WSF(YBUF)[(size_t)(t0 + l_) * 512 + hh * 64 + pp] = acc;
      }
    }
    {
      const int n = tid & 127, pg = tid >> 7;
      float acc[32];
#pragma unroll
      for (int j = 0; j < 32; ++j) acc[j] = 0.f;
      const float alast = acs_s[127];
      for (int li = 0; li < 128; ++li) {
        const float bw = WSF(XBC)[(size_t)(t0 + li) * 1024 + 512 + g * 128 + n] * expf(alast - acs_s[li]);
#pragma unroll
        for (int j = 0; j < 32; ++j) acc[j] += bw * xdt[li][pg * 32 + j];
      }
      float* sp = WSF(STATES) + ((size_t)(bc * 8 + hh) * 64) * 128;
#pragma unroll
      for (int j = 0; j < 32; ++j) sp[(pg * 32 + j) * 128 + n] = acc[j];
    }
  }
  __syncthreads();
}

__device__ void phase_scan(const Params& p) {
  const int gtid = blockIdx.x * NTHR + TIDX, gsz = gridDim.x * NTHR;
  for (int idx = gtid; idx < NB * 8 * 64 * 128; idx += gsz) {
    const int pn = idx & 8191, hh = (idx >> 13) & 7, b = idx >> 16;
    float Sv = 0.f;
    for (int c = 0; c < 64; ++c) {
      const size_t off = ((size_t)((b * 64 + c) * 8 + hh)) * 8192 + pn;
      const float tmp = WSF(STATES)[off];
      WSF(STATES)[off] = Sv;
      Sv = expf(WSF(ACS)[(b * S + c * 128 + 127) * 8 + hh]) * Sv + tmp;
    }
  }
}

__device__ void phase_ssd_off(const Params& p, int l, float* smem) {
  float (*Sin)[129] = (float (*)[129])smem;
  float* acs_s = smem + 64 * 129;
  const int tid = TIDX, lane = tid & 63;
  for (int item = blockIdx.x; item < NB * 64 * 8; item += gridDim.x) {
    const int hh = item & 7, bc = item >> 3, g = hh >> 2, t0 = bc * 128;
    __syncthreads();
    const float* sp = WSF(STATES) + ((size_t)(bc * 8 + hh) * 64) * 128;
    for (int i = tid; i < 64 * 128; i += NTHR) Sin[i >> 7][i & 127] = sp[i];
    if (tid < 128) acs_s[tid] = WSF(ACS)[(t0 + tid) * 8 + hh];
    __syncthreads();
    const int pp = lane, lg = tid >> 6;
    const float dsk = p.d_skip[l * 8 + hh];
    for (int li = 0; li < 32; ++li) {
      const int l_ = lg + 4 * li;
      const float* cr = WSF(XBC) + (size_t)(t0 + l_) * 1024 + 768 + g * 128;
      float acc = 0.f;
#pragma unroll 8
      for (int n = 0; n < 128; ++n) acc += cr[n] * Sin[pp][n];
      const size_t yo = (size_t)(t0 + l_) * 512 + hh * 64 + pp;
      WSF(YBUF)[yo] = WSF(YBUF)[yo] + expf(acs_s[l_]) * acc + dsk * WSF(XBC)[(size_t)(t0 + l_) * 1024 + hh * 64 + pp];
    }
  }
  __syncthreads();
}

__device__ void phase_mix_norm(const Params& p, int l) {
  const int wave = (blockIdx.x * NTHR + TIDX) >> 6, nw = gridDim.x * (NTHR / 64), lane = TIDX & 63;
  for (int item = wave; item < T * 3; item += nw) {
    const int t = item / 3, part = item % 3;
    if (part == 0) {
      float4 v[2]; float ss = 0.f;
#pragma unroll
      for (int i = 0; i < 2; ++i) {
        const int col = (lane + 64 * i) * 4;
        const float4 y = *(const float4*)(WSF(YBUF) + (size_t)t * 512 + col);
        const float4 z = *(const float4*)(WSF(PROJ) + (size_t)t * NIN + C_Z + col);
        v[i].x = y.x * siluf(z.x); v[i].y = y.y * siluf(z.y); v[i].z = y.z * siluf(z.z); v[i].w = y.w * siluf(z.w);
        ss += v[i].x * v[i].x + v[i].y * v[i].y + v[i].z * v[i].z + v[i].w * v[i].w;
      }
      ss = wave_sum(ss);
      const float inv = rsqrtf(ss * (1.f / 512.f) + 1e-5f);
#pragma unroll
      for (int i = 0; i < 2; ++i) {
        const int col = (lane + 64 * i) * 4;
        const float4 g4 = *(const float4*)(p.ssd_norm_g + l * 512 + col);
        *(uint2*)(WSH(YCATB) + (size_t)t * 1024 + col) = make_uint2(pack2bf(v[i].x * inv * g4.x, v[i].y * inv * g4.y), pack2bf(v[i].z * inv * g4.z, v[i].w * inv * g4.w));
      }
    } else {
      const int col0 = part == 1 ? 512 : 768;
      const float* gp = part == 1 ? p.moba_norm_g + l * 256 : p.swa_norm_g + l * 256;
      float4* yp = (float4*)(WSF(YCAT) + (size_t)t * 1024 + col0 + lane * 4);
      const float4 v = *yp;
      float ss = wave_sum(v.x * v.x + v.y * v.y + v.z * v.z + v.w * v.w);
      const float inv = rsqrtf(ss * (1.f / 256.f) + 1e-5f);
      const float4 g4 = *(const float4*)(gp + lane * 4);
      *(uint2*)(WSH(YCATB) + (size_t)t * 1024 + col0 + lane * 4) = make_uint2(pack2bf(v.x * inv * g4.x, v.y * inv * g4.y), pack2bf(v.z * inv * g4.z, v.w * inv * g4.w));
    }
  }
}

__device__ void phase_moba(const Params& p) {
  const int gtid = blockIdx.x * NTHR + TIDX, gsz = gridDim.x * NTHR;
  for (int idx = gtid; idx < T * 4; idx += gsz) {
    const int hh = idx / T, t = idx % T, b = t / S, s = t & (S - 1), blk = s >> 8;
    float4 q[16], o[16];
    const float4* qp = (const float4*)(WSF(PROJ) + (size_t)t * NIN + C_MQ + hh * 64);
#pragma unroll
    for (int i = 0; i < 16; ++i) { q[i] = qp[i]; o[i] = make_float4(0.f, 0.f, 0.f, 0.f); }
    float v0 = -INFINITY, v1 = -INFINITY, v2 = -INFINITY; int i0 = 0, i1 = 0, i2 = 0;
#pragma unroll 1
    for (int n = 0; n < blk; ++n) {
      const float4* kp = (const float4*)(WSF(KMEAN) + ((b * 4 + hh) * 32 + n) * 64);
      float gsc = 0.f;
#pragma unroll
      for (int i = 0; i < 16; ++i) { const float4 k = kp[i]; gsc += q[i].x * k.x + q[i].y * k.y + q[i].z * k.z + q[i].w * k.w; }
      if (gsc > v0) { v2 = v1; i2 = i1; v1 = v0; i1 = i0; v0 = gsc; i0 = n; }
      else if (gsc > v1) { v2 = v1; i2 = i1; v1 = gsc; i1 = n; }
      else if (gsc > v2) { v2 = gsc; i2 = n; }
    }
    const int nsel = blk < 3 ? blk : 3;
    float m = -INFINITY, lsum = 0.f;
    for (int j = 0; j <= nsel; ++j) {
      int kb, cnt;
      if (j < nsel) { kb = (j == 0 ? i0 : (j == 1 ? i1 : i2)); cnt = 256; }
      else { kb = blk; cnt = (s & 255) + 1; }
      const size_t row0 = (size_t)(b * S + kb * 256);
#pragma unroll 1
      for (int kk = 0; kk < cnt; ++kk) {
        const float4* kp = (const float4*)(WSF(PROJ) + (row0 + kk) * NIN + C_MK + hh * 64);
        float sc = 0.f;
#pragma unroll
        for (int i = 0; i < 16; ++i) { const float4 k = kp[i]; sc += q[i].x * k.x + q[i].y * k.y + q[i].z * k.z + q[i].w * k.w; }
        sc *= 0.125f;
        if (sc > m) {
          const float corr = expf(m - sc);
          lsum *= corr;
#pragma unroll
          for (int i = 0; i < 16; ++i) { o[i].x *= corr; o[i].y *= corr; o[i].z *= corr; o[i].w *= corr; }
          m = sc;
        }
        const float pe = expf(sc - m);
        lsum += pe;
        const float4* vp = (const float4*)(WSF(PROJ) + (row0 + kk) * NIN + C_MV + hh * 64);
#pragma unroll
        for (int i = 0; i < 16; ++i) { const float4 v = vp[i]; o[i].x += pe * v.x; o[i].y += pe * v.y; o[i].z += pe * v.z; o[i].w += pe * v.w; }
      }
    }
    const float inv = 1.f / lsum;
    float4* op = (float4*)(WSF(YCAT) + (size_t)t * 1024 + 512 + hh * 64);
#pragma unroll
    for (int i = 0; i < 16; ++i) op[i] = make_float4(o[i].x * inv, o[i].y * inv, o[i].z * inv, o[i].w * inv);
  }
}

__device__ void phase_moba_gate(const Params& p) {
  const int gtid = blockIdx.x * NTHR + TIDX, gsz = gridDim.x * NTHR;
  for (int idx = gtid; idx < T * 4; idx += gsz) {
    const int hh = idx / T, t = idx % T, b = t / S, s = t & (S - 1), blk = s >> 8;
    float4 q[16];
    const float4* qp = (const float4*)(WSF(PROJ) + (size_t)t * NIN + C_MQ + hh * 64);
#pragma unroll
    for (int i = 0; i < 16; ++i) q[i] = qp[i];
    float v0 = -INFINITY, v1 = -INFINITY, v2 = -INFINITY; int i0 = 63, i1 = 63, i2 = 63;
#pragma unroll 2
    for (int n = 0; n < blk; ++n) {
      const float4* kp = (const float4*)(WSF(KMEAN) + ((b * 4 + hh) * 32 + n) * 64);
      float gsc = 0.f;
#pragma unroll
      for (int i = 0; i < 16; ++i) { const float4 k = kp[i]; gsc += q[i].x * k.x + q[i].y * k.y + q[i].z * k.z + q[i].w * k.w; }
      if (gsc > v0) { v2 = v1; i2 = i1; v1 = v0; i1 = i0; v0 = gsc; i0 = n; }
      else if (gsc > v1) { v2 = v1; i2 = i1; v1 = gsc; i1 = n; }
      else if (gsc > v2) { v2 = gsc; i2 = n; }
    }
    WSI(MSEL)[(size_t)t * 4 + hh] = i0 | (i1 << 6) | (i2 << 12);
  }
}

struct AttnSt { f32x16 o0, o1; float m, l; };
typedef short bf16x4 __attribute__((ext_vector_type(4)));
__device__ __forceinline__ void attn_tile(const bf16_t* __restrict__ Kb, int ldk, const bf16_t* __restrict__ Vtb, int kt0, const bf16x8 (&qf)[4], int lo, int hi, float c, int lane, AttnSt& st) {
  const int h = lane >> 5, r31 = lane & 31;
  f32x16 s0, s1;
#pragma unroll
  for (int r = 0; r < 16; ++r) { s0[r] = 0.f; s1[r] = 0.f; }
  {
    const bf16_t* kp = Kb + (size_t)(kt0 + r31) * ldk + 8 * h;
#pragma unroll
    for (int ks = 0; ks < 4; ++ks) {
      const bf16x8 k0 = *(const bf16x8*)(kp + 16 * ks);
      const bf16x8 k1 = *(const bf16x8*)(kp + (size_t)32 * ldk + 16 * ks);
      s0 = __builtin_amdgcn_mfma_f32_32x32x16_bf16(k0, qf[ks], s0, 0, 0, 0);
      s1 = __builtin_amdgcn_mfma_f32_32x32x16_bf16(k1, qf[ks], s1, 0, 0, 0);
    }
  }
  bf16x8 vf0[4], vf1[4];
  {
    const bf16_t* vp = Vtb + (size_t)r31 * S + kt0 + 4 * h;
#pragma unroll
    for (int ks = 0; ks < 4; ++ks) {
      const int off = (ks >> 1) * 32 + (ks & 1) * 16;
      const bf16x4 a0 = *(const bf16x4*)(vp + off), a1 = *(const bf16x4*)(vp + off + 8);
      const bf16x4 b0 = *(const bf16x4*)(vp + (size_t)32 * S + off), b1 = *(const bf16x4*)(vp + (size_t)32 * S + off + 8);
      vf0[ks] = (bf16x8){a0[0], a0[1], a0[2], a0[3], a1[0], a1[1], a1[2], a1[3]};
      vf1[ks] = (bf16x8){b0[0], b0[1], b0[2], b0[3], b1[0], b1[1], b1[2], b1[3]};
    }
  }
  const int klo = lo - kt0 - 4 * h, khi = hi - kt0 - 4 * h;
  float tmax = -INFINITY;
#pragma unroll
  for (int r = 0; r < 16; ++r) {
    const int k0c = (r & 3) + 8 * (r >> 2);
    s0[r] = (k0c >= klo && k0c <= khi) ? s0[r] : -INFINITY;
    s1[r] = (k0c + 32 >= klo && k0c + 32 <= khi) ? s1[r] : -INFINITY;
    tmax = fmaxf(tmax, fmaxf(s0[r], s1[r]));
  }
  tmax = fmaxf(tmax, __shfl_xor(tmax, 32));
  const float mnew = fmaxf(st.m, tmax * c);
  const float msafe = (mnew == -INFINITY) ? 0.f : mnew;
  const float alpha = __builtin_amdgcn_exp2f(st.m - msafe);
  st.m = mnew;
  float psum = 0.f;
#pragma unroll
  for (int r = 0; r < 16; ++r) {
    s0[r] = __builtin_amdgcn_exp2f(fmaf(s0[r], c, -msafe));
    s1[r] = __builtin_amdgcn_exp2f(fmaf(s1[r], c, -msafe));
    psum += s0[r] + s1[r];
  }
  st.l = st.l * alpha + psum;
  if (__any(alpha != 1.f)) {
#pragma unroll
    for (int r = 0; r < 16; ++r) { st.o0[r] *= alpha; st.o1[r] *= alpha; }
  }
  bf16x8 pf[4];
#pragma unroll
  for (int ks = 0; ks < 4; ++ks) {
    const int r0 = (ks & 1) * 8;
    unsigned w[4];
#pragma unroll
    for (int j = 0; j < 4; ++j) w[j] = (ks >> 1) ? pack2bf(s1[r0 + 2 * j], s1[r0 + 2 * j + 1]) : pack2bf(s0[r0 + 2 * j], s0[r0 + 2 * j + 1]);
    pf[ks] = (bf16x8){(short)(w[0] & 0xffff), (short)(w[0] >> 16), (short)(w[1] & 0xffff), (short)(w[1] >> 16), (short)(w[2] & 0xffff), (short)(w[2] >> 16), (short)(w[3] & 0xffff), (short)(w[3] >> 16)};
  }
#pragma unroll
  for (int ks = 0; ks < 4; ++ks) {
    st.o0 = __builtin_amdgcn_mfma_f32_32x32x16_bf16(vf0[ks], pf[ks], st.o0, 0, 0, 0);
    st.o1 = __builtin_amdgcn_mfma_f32_32x32x16_bf16(vf1[ks], pf[ks], st.o1, 0, 0, 0);
  }
}

__device__ void phase_attn(const Params& p, int l, char* smem) {
  const int tid = TIDX, lane = tid & 63, w = tid >> 6, h = lane >> 5, ql = lane & 31;
  const float c = 0.125f * 1.4426950408889634f;
  float* mO = (float*)smem;
  float* mM = (float*)(smem + 32768);
  float* mL = mM + 256;
  const int nblk = gridDim.x;
  for (int it = 0;; ++it) {
    const int rank = it * nblk + ((it & 1) ? (nblk - 1 - (int)blockIdx.x) : (int)blockIdx.x);
    if (rank >= 4096) break;
    AttnSt st;
#pragma unroll
    for (int r = 0; r < 16; ++r) { st.o0[r] = 0.f; st.o1[r] = 0.f; }
    st.m = -INFINITY; st.l = 0.f;
    float sinkv = -INFINITY; float* outp; int q0, b;
    if (rank < 2048) {
      const int qt = 255 - (rank >> 3), bh = rank & 7, hh = bh & 3;
      b = bh >> 2; q0 = qt * 32;
      const int blk = q0 >> 8, n_own = ((q0 & 255) + 31) / 64 + 1;
      const size_t t = (size_t)b * S + q0 + ql;
      bf16x8 qf[4];
#pragma unroll
      for (int ks = 0; ks < 4; ++ks) qf[ks] = *(const bf16x8*)(WSH(MQK) + t * 512 + hh * 64 + 16 * ks + 8 * h);
      const int msel = WSI(MSEL)[t * 4 + hh];
      const int s0i = msel & 63, s1i = (msel >> 6) & 63, s2i = (msel >> 12) & 63;
      const bf16_t* Kb = WSH(MQK) + (size_t)b * S * 512 + 256 + hh * 64;
      const bf16_t* Vtb = WSH(MVT) + (size_t)(b * 4 + hh) * 64 * S;
      for (int j = 0; j < blk; ++j) {
        const bool sel = (j == s0i) || (j == s1i) || (j == s2i);
        if (!__any(sel)) continue;
        attn_tile(Kb, 512, Vtb, j * 256 + w * 64, qf, sel ? 0 : (1 << 30), 1 << 30, c, lane, st);
      }
      if (w < n_own) attn_tile(Kb, 512, Vtb, blk * 256 + w * 64, qf, 0, q0 + ql, c, lane, st);
      outp = WSF(YCAT) + t * 1024 + 512 + hh * 64;
    } else {
      const int r2 = rank - 2048, qt = r2 & 255, hq = (r2 >> 8) & 3, kvh = hq >> 1;
      b = r2 >> 10; q0 = qt * 32;
      const size_t t = (size_t)b * S + q0 + ql;
      bf16x8 qf[4];
#pragma unroll
      for (int ks = 0; ks < 4; ++ks) qf[ks] = *(const bf16x8*)(WSH(SQK) + t * 384 + hq * 64 + 16 * ks + 8 * h);
      const bf16_t* Kb = WSH(SQK) + (size_t)b * S * 384 + 256 + kvh * 64;
      const bf16_t* Vtb = WSH(SVT) + (size_t)(b * 2 + kvh) * 64 * S;
      const int first = (q0 >= 127 ? q0 - 127 : 0) >> 6, last = (q0 + 31) >> 6;
      if (first + w <= last) attn_tile(Kb, 384, Vtb, (first + w) * 64, qf, q0 + ql - 127, q0 + ql, c, lane, st);
      sinkv = p.swa_sinks[l * 4 + hq] * 1.4426950408889634f;
      outp = WSF(YCAT) + t * 1024 + 768 + hq * 64;
    }
    st.l += __shfl_xor(st.l, 32);
    __syncthreads();
#pragma unroll
    for (int r = 0; r < 16; ++r) { mO[(w * 32 + r) * 64 + lane] = st.o0[r]; mO[(w * 32 + 16 + r) * 64 + lane] = st.o1[r]; }
    mM[w * 64 + lane] = st.m; mL[w * 64 + lane] = st.l;
    __syncthreads();
    if (w == 0) {
      float mm[4], M = sinkv;
#pragma unroll
      for (int i = 0; i < 4; ++i) { mm[i] = mM[i * 64 + lane]; M = fmaxf(M, mm[i]); }
      float L = (sinkv == -INFINITY) ? 0.f : __builtin_amdgcn_exp2f(sinkv - M);
      float f[4];
#pragma unroll
      for (int i = 0; i < 4; ++i) { f[i] = __builtin_amdgcn_exp2f(mm[i] - M); L += mL[i * 64 + lane] * f[i]; }
      const float inv = 1.f / L;
#pragma unroll
      for (int dt = 0; dt < 2; ++dt)
#pragma unroll
        for (int g = 0; g < 4; ++g) {
          float4 o;
          float* op = &o.x;
#pragma unroll
          for (int j = 0; j < 4; ++j) {
            const int r = dt * 16 + g * 4 + j;
            op[j] = (mO[(0 * 32 + r) * 64 + lane] * f[0] + mO[(1 * 32 + r) * 64 + lane] * f[1] + mO[(2 * 32 + r) * 64 + lane] * f[2] + mO[(3 * 32 + r) * 64 + lane] * f[3]) * inv;
          }
          *(float4*)(outp + dt * 32 + g * 8 + 4 * h) = o;
        }
    }
  }
  __syncthreads();
}

__device__ void phase_swa(const Params& p, int l) {
  const int gtid = blockIdx.x * NTHR + TIDX, gsz = gridDim.x * NTHR;
  for (int idx = gtid; idx < T * 4; idx += gsz) {
    const int hh = idx / T, t = idx % T, s = t & (S - 1), kvh = hh >> 1;
    float4 q[16], o[16];
    const float4* qp = (const float4*)(WSF(PROJ) + (size_t)t * NIN + C_SQ + hh * 64);
#pragma unroll
    for (int i = 0; i < 16; ++i) { q[i] = qp[i]; o[i] = make_float4(0.f, 0.f, 0.f, 0.f); }
    const float sink = p.swa_sinks[l * 4 + hh];
    float m = sink, lsum = 1.f;
    const int cnt = s < 127 ? s + 1 : 128;
    const size_t row0 = (size_t)(t - cnt + 1);
#pragma unroll 1
    for (int kk = 0; kk < cnt; ++kk) {
      const float4* kp = (const float4*)(WSF(PROJ) + (row0 + kk) * NIN + C_SK + kvh * 64);
      float sc = 0.f;
#pragma unroll
      for (int i = 0; i < 16; ++i) { const float4 k = kp[i]; sc += q[i].x * k.x + q[i].y * k.y + q[i].z * k.z + q[i].w * k.w; }
      sc *= 0.125f;
      if (sc > m) {
        const float corr = expf(m - sc);
        lsum *= corr;
#pragma unroll
        for (int i = 0; i < 16; ++i) { o[i].x *= corr; o[i].y *= corr; o[i].z *= corr; o[i].w *= corr; }
        m = sc;
      }
      const float pe = expf(sc - m);
      lsum += pe;
      const float4* vp = (const float4*)(WSF(PROJ) + (row0 + kk) * NIN + C_SV + kvh * 64);
#pragma unroll
      for (int i = 0; i < 16; ++i) { const float4 v = vp[i]; o[i].x += pe * v.x; o[i].y += pe * v.y; o[i].z += pe * v.z; o[i].w += pe * v.w; }
    }
    const float inv = 1.f / lsum;
    float4* op = (float4*)(WSF(YCAT) + (size_t)t * 1024 + 768 + hh * 64);
#pragma unroll
    for (int i = 0; i < 16; ++i) op[i] = make_float4(o[i].x * inv, o[i].y * inv, o[i].z * inv, o[i].w * inv);
  }
}

__device__ __forceinline__ unsigned fkey(float v) { const unsigned u = __float_as_uint(v); return (u & 0x80000000u) ? ~u : (u | 0x80000000u); }
template <unsigned MASK> __device__ __forceinline__ float kval(unsigned k) {
  const unsigned u = (k & 0x80000000u) ? (k & 0x7fffffffu) : ~k;
  return __uint_as_float(u & ~MASK);
}
__device__ __forceinline__ void ins16(unsigned (&L)[16], unsigned x) {
#pragma unroll
  for (int j = 0; j < 16; ++j) { const unsigned hi = max(L[j], x); x = min(L[j], x); L[j] = hi; }
}
__device__ __forceinline__ unsigned csel(unsigned cond, unsigned a, unsigned b) {
  unsigned r;
  asm("v_cmp_ne_u32 vcc, 0, %1\n\tv_cndmask_b32 %0, %2, %3, vcc" : "=v"(r) : "v"(cond), "v"(a), "v"(b) : "vcc");
  return r;
}
__device__ __forceinline__ unsigned sel16(const unsigned (&A)[16], unsigned a) {
  const unsigned b0 = a & 1u, b1 = a & 2u, b2 = a & 4u, b3 = a & 8u;
  const unsigned t0 = csel(b0, A[0], A[1]), t1 = csel(b0, A[2], A[3]), t2 = csel(b0, A[4], A[5]), t3 = csel(b0, A[6], A[7]);
  const unsigned t4 = csel(b0, A[8], A[9]), t5 = csel(b0, A[10], A[11]), t6 = csel(b0, A[12], A[13]), t7 = csel(b0, A[14], A[15]);
  const unsigned u0 = csel(b1, t0, t1), u1 = csel(b1, t2, t3), u2 = csel(b1, t4, t5), u3 = csel(b1, t6, t7);
  const unsigned w0 = csel(b2, u0, u1), w1 = csel(b2, u2, u3);
  return csel(b3, w0, w1);
}
__device__ __forceinline__ void peer_half_top16(const char* kmat, const bf16_t* qcol, const int (&aoff)[8], int h4, unsigned (&L)[16]) {
  bf16x8 bq[8];
#pragma unroll
  for (int s = 0; s < 8; ++s) bq[s] = *(const bf16x8*)(qcol + s * 8);
#pragma unroll
  for (int j = 0; j < 16; ++j) L[j] = 0u;
#pragma unroll
  for (int nt = 0; nt < 4; ++nt) {
    f32x16 acc;
#pragma unroll
    for (int r = 0; r < 16; ++r) acc[r] = 0.f;
#pragma unroll
    for (int s = 0; s < 8; ++s) {
      const bf16x8 ak = *(const bf16x8*)(kmat + nt * 8192 + aoff[s]);
      acc = __builtin_amdgcn_mfma_f32_32x32x16_bf16(ak, bq[s], acc, 0, 0, 0);
    }
#pragma unroll
    for (int r = 0; r < 16; ++r) {
      const int nconst = nt * 32 + (r & 3) + 8 * (r >> 2);
      ins16(L, (fkey(acc[r]) & ~127u) | (unsigned)(127 - nconst - h4));
    }
    __builtin_amdgcn_sched_barrier(0);
  }
  unsigned P[16];
#pragma unroll
  for (int j = 0; j < 16; ++j) P[j] = __shfl_xor(L[j], 32);
#pragma unroll
  for (int j = 0; j < 16; ++j) ins16(L, P[j]);
}
__device__ void phase_peer_topk2(const Params& p, int l, char* smem) {
  const int tid = TIDX, lane = tid & 63;
  {
    const uint4* ksrc = (const uint4*)(WSH(K12B) + (size_t)l * 32768);
    for (int i = tid; i < 4096; i += NTHR) {
      const int mat = i >> 11, r = (i >> 4) & 127, c = i & 15;
      *(uint4*)(smem + mat * 32768 + r * 256 + ((c ^ (r & 15)) << 4)) = ksrc[i];
    }
  }
  __syncthreads();
  const int h = lane >> 5, cl = lane & 31;
  int aoff[8];
#pragma unroll
  for (int s = 0; s < 8; ++s) aoff[s] = cl * 256 + ((((h * 8) ^ (lane & 15)) ^ s) << 4);
  const int gw = (blockIdx.x * NTHR + tid) >> 6, nw = gridDim.x * (NTHR / 64);
  for (int unit = gw; unit < T * 8 / 32; unit += nw) {
    const size_t col = (size_t)unit * 32 + cl;
    const bf16_t* qcol = WSH(QB) + col * 256 + h * 64;
    unsigned L1[16], L2[16];
    peer_half_top16(smem, qcol, aoff, 4 * h, L1);
    peer_half_top16(smem + 32768, qcol + 128, aoff, 4 * h, L2);
    float v1[16], v2[16];
#pragma unroll
    for (int j = 0; j < 16; ++j) { v1[j] = kval<127u>(L1[j]); v2[j] = kval<127u>(L2[j]); }
    unsigned C[16];
#pragma unroll
    for (int j = 0; j < 16; ++j) C[j] = 0u;
#pragma unroll
    for (int a = 0; a < 16; ++a)
#pragma unroll
      for (int b = 0; b < 16; ++b)
        if ((a + 1) * (b + 1) <= 16) { ins16(C, (fkey(v1[a] + v2[b]) & ~255u) | (unsigned)(255 - (a * 16 + b))); if ((b & 3) == 3 || (a + 1) * (b + 2) > 16) __builtin_amdgcn_sched_barrier(0); }
    unsigned I1[16], I2[16];
#pragma unroll
    for (int j = 0; j < 16; ++j) { I1[j] = 127u - (L1[j] & 127u); I2[j] = 127u - (L2[j] & 127u); }
    float ex[16]; unsigned ee[16]; float sum = 0.f;
    const float mx = kval<255u>(C[0]);
#pragma unroll
    for (int k = 0; k < 16; ++k) {
      const unsigned ci = 255u - (C[k] & 255u);
      ee[k] = sel16(I1, ci >> 4) * 128u + sel16(I2, ci & 15u);
      ex[k] = __expf(kval<255u>(C[k]) - mx);
      sum += ex[k];
    }
    const float inv = 1.f / sum;
    unsigned* dst = h ? (unsigned*)(WSF(GVAL) + col * 16) : (unsigned*)(WSI(EIDX) + col * 16);
#pragma unroll
    for (int k4 = 0; k4 < 4; ++k4) {
      uint4 w;
      w.x = h ? __float_as_uint(ex[4 * k4 + 0] * inv) : ee[4 * k4 + 0];
      w.y = h ? __float_as_uint(ex[4 * k4 + 1] * inv) : ee[4 * k4 + 1];
      w.z = h ? __float_as_uint(ex[4 * k4 + 2] * inv) : ee[4 * k4 + 2];
      w.w = h ? __float_as_uint(ex[4 * k4 + 3] * inv) : ee[4 * k4 + 3];
      *(uint4*)(dst + 4 * k4) = w;
    }
  }
  __syncthreads();
}

__device__ void phase_peer_topk(const Params& p) {
  const int wave = (blockIdx.x * NTHR + TIDX) >> 6, nw = gridDim.x * (NTHR / 64), lane = TIDX & 63;
  for (int row = wave; row < T * 8; row += nw) {
    float myv1 = 0.f, myv2 = 0.f; int myi1 = 0, myi2 = 0;
    {
      float a0 = WSF(S1)[(size_t)row * 128 + lane], a1 = WSF(S1)[(size_t)row * 128 + 64 + lane];
      for (int r = 0; r < 16; ++r) {
        float v; int i;
        if (a0 >= a1) { v = a0; i = lane; } else { v = a1; i = lane + 64; }
        wave_argmax(v, i);
        if (i == lane) a0 = -INFINITY; else if (i == lane + 64) a1 = -INFINITY;
        if (lane == r) { myv1 = v; myi1 = i; }
      }
    }
    {
      float a0 = WSF(S2)[(size_t)row * 128 + lane], a1 = WSF(S2)[(size_t)row * 128 + 64 + lane];
      for (int r = 0; r < 16; ++r) {
        float v; int i;
        if (a0 >= a1) { v = a0; i = lane; } else { v = a1; i = lane + 64; }
        wave_argmax(v, i);
        if (i == lane) a0 = -INFINITY; else if (i == lane + 64) a1 = -INFINITY;
        if (lane == r) { myv2 = v; myi2 = i; }
      }
    }
    float cd[4];
#pragma unroll
    for (int j = 0; j < 4; ++j) cd[j] = __shfl(myv1, (lane >> 4) + 4 * j) + __shfl(myv2, lane & 15);
    float scv = 0.f; int cidx = 0;
    for (int r = 0; r < 16; ++r) {
      float v = cd[0]; int i = lane;
#pragma unroll
      for (int j = 1; j < 4; ++j) if (cd[j] > v) { v = cd[j]; i = lane + 64 * j; }
      wave_argmax(v, i);
      if ((i & 63) == lane) {
        const int j = i >> 6;
        if (j == 0) cd[0] = -INFINITY; else if (j == 1) cd[1] = -INFINITY; else if (j == 2) cd[2] = -INFINITY; else cd[3] = -INFINITY;
      }
      if (lane == r) { scv = v; cidx = i; }
    }
    const int e1 = __shfl(myi1, (cidx >> 4) & 63), e2 = __shfl(myi2, cidx & 15);
    const float mx = __shfl(scv, 0);
    const float ex = lane < 16 ? expf(scv - mx) : 0.f;
    const float sum = wave_sum(ex);
    if (lane < 16) { WSI(EIDX)[(size_t)row * 16 + lane] = e1 * 128 + e2; WSF(GVAL)[(size_t)row * 16 + lane] = ex / sum; }
  }
}

__device__ __forceinline__ float dot8(const uint4 w, const float* h) {
  return bflo(w.x) * h[0] + bfhi(w.x) * h[1] + bflo(w.y) * h[2] + bfhi(w.y) * h[3] + bflo(w.z) * h[4] + bfhi(w.z) * h[5] + bflo(w.w) * h[6] + bfhi(w.w) * h[7];
}
__device__ __forceinline__ void axpy8(float a, const uint4 w, float* acc) {
  acc[0] += a * bflo(w.x); acc[1] += a * bfhi(w.x); acc[2] += a * bflo(w.y); acc[3] += a * bfhi(w.y);
  acc[4] += a * bflo(w.z); acc[5] += a * bfhi(w.z); acc[6] += a * bflo(w.w); acc[7] += a * bfhi(w.w);
}
__device__ void phase_peer_expert(const Params& p, int l) {
  const int wave = (blockIdx.x * NTHR + TIDX) >> 6, nw = gridDim.x * (NTHR / 64), lane = TIDX & 63;
  const uint4* U = (const uint4*)(WSH(UB) + (size_t)l * 16384 * 1024);
  const uint4* V = (const uint4*)(WSH(VB) + (size_t)l * 16384 * 1024);
  const float* g2 = WSF(MOD) + (size_t)l * 2 * 6 * D + 5 * D;
  for (int t = wave; t < T; t += nw) {
    float h[16], acc[16];
    {
      const float4* hr = (const float4*)(WSF(H) + (size_t)t * D);
      const float4 a = hr[lane * 2], b = hr[lane * 2 + 1], c = hr[128 + lane * 2], d = hr[128 + lane * 2 + 1];
      h[0] = a.x; h[1] = a.y; h[2] = a.z; h[3] = a.w; h[4] = b.x; h[5] = b.y; h[6] = b.z; h[7] = b.w;
      h[8] = c.x; h[9] = c.y; h[10] = c.z; h[11] = c.w; h[12] = d.x; h[13] = d.y; h[14] = d.z; h[15] = d.w;
    }
#pragma unroll
    for (int i = 0; i < 16; ++i) acc[i] = 0.f;
    for (int p0 = 0; p0 < 128; p0 += 64) {
      const int my_e = WSI(EIDX)[(size_t)t * 128 + p0 + lane];
      const float my_g = WSF(GVAL)[(size_t)t * 128 + p0 + lane];
#pragma unroll 1
      for (int j = 0; j < 64; j += 4) {
        int e[4]; float gg[4]; uint4 u0[4], u1[4], v0[4], v1[4];
#pragma unroll
        for (int q = 0; q < 4; ++q) {
          e[q] = __shfl(my_e, j + q); gg[q] = __shfl(my_g, j + q);
          const uint4* ur = U + (size_t)e[q] * 128; const uint4* vr = V + (size_t)e[q] * 128;
          u0[q] = ur[lane]; u1[q] = ur[64 + lane]; v0[q] = vr[lane]; v1[q] = vr[64 + lane];
        }
        float d[4];
#pragma unroll
        for (int q = 0; q < 4; ++q) d[q] = dot8(u0[q], h) + dot8(u1[q], h + 8);
#pragma unroll
        for (int o = 32; o > 0; o >>= 1) {
#pragma unroll
          for (int q = 0; q < 4; ++q) d[q] += __shfl_xor(d[q], o);
        }
#pragma unroll
        for (int q = 0; q < 4; ++q) {
          const float act = 0.5f * d[q] * (1.f + erff(d[q] * 0.70710678118654752f)) * gg[q];
          axpy8(act, v0[q], acc); axpy8(act, v1[q], acc + 8);
        }
      }
    }
    const int b = t / S;
    float* xr = WSF(XCUR) + (size_t)t * D;
#pragma unroll
    for (int hlf = 0; hlf < 2; ++hlf)
#pragma unroll
      for (int q = 0; q < 2; ++q) {
        const int col = hlf * 512 + lane * 8 + q * 4;
        const float4 gt = *(const float4*)(g2 + b * 6 * D + col);
        float4 xv = *(float4*)(xr + col);
        xv.x += gt.x * acc[hlf * 8 + q * 4 + 0]; xv.y += gt.y * acc[hlf * 8 + q * 4 + 1]; xv.z += gt.z * acc[hlf * 8 + q * 4 + 2]; xv.w += gt.w * acc[hlf * 8 + q * 4 + 3];
        *(float4*)(xr + col) = xv;
      }
  }
}

__device__ void phase_final(const Params& p) {
  const int wave = (blockIdx.x * NTHR + TIDX) >> 6, nw = gridDim.x * (NTHR / 64), lane = TIDX & 63;
  for (int t = wave; t < T; t += nw) {
    const float4* xr = (const float4*)(WSF(XCUR) + (size_t)t * D);
    float4 v[4]; float ss = 0.f;
#pragma unroll
    for (int i = 0; i < 4; ++i) { v[i] = xr[lane + 64 * i]; ss += v[i].x * v[i].x + v[i].y * v[i].y + v[i].z * v[i].z + v[i].w * v[i].w; }
    ss = wave_sum(ss);
    const float inv = rsqrtf(ss * (1.f / D) + 1e-5f);
    float4* orow = (float4*)(p.out + (size_t)t * D);
#pragma unroll
    for (int i = 0; i < 4; ++i) {
      const float4 g4 = *(const float4*)(p.final_g + (lane + 64 * i) * 4);
      orow[lane + 64 * i] = make_float4(v[i].x * inv * g4.x, v[i].y * inv * g4.y, v[i].z * inv * g4.z, v[i].w * inv * g4.w);
    }
  }
}

__device__ __forceinline__ void gsync(cg::grid_group& g) {
  asm volatile("s_waitcnt vmcnt(0)" ::: "memory");
  __syncthreads();
  g.sync();
  __builtin_amdgcn_fence(__ATOMIC_ACQUIRE, "agent");
  asm volatile("s_waitcnt vmcnt(0)" ::: "memory");
}

__global__ void __launch_bounds__(NTHR, 2) hymba_fwd(Params p) {
  cg::grid_group grid = cg::this_grid();
  __shared__ __attribute__((aligned(16))) char smem_c[65536];
  float* smem = (float*)smem_c;
  phase_mod(p, smem);
  phase_prologue_weights(p, smem);
  gsync(grid);
#pragma unroll 1
  for (int l = 0; l < NL; ++l) {
    const float* modl = WSF(MOD) + (size_t)l * 2 * 6 * D;
    phase_norm_mod(WSF(XCUR), p.norm1_g + l * D, modl + 1 * D, modl + 0 * D, WSF(H), WSH(HB));
    gsync(grid);
    gemm_bf16(WSH(HB), D, WSH(WINT) + (size_t)l * NINP * D, D, T, NINP, D, EpiInProj{WSF(PROJ), WSH(MQK), WSH(MVT), WSH(SQK), WSH(SVT)}, smem_c);
    gsync(grid);
    phase_conv_dt_kmean(p, l);
    gsync(grid);
    phase_cb(p);
    phase_moba_gate(p);
    gsync(grid);
    phase_ssd_chunk(p, smem);
    phase_attn(p, l, smem_c);
    gsync(grid);
    phase_scan(p);
    gsync(grid);
    phase_ssd_off(p, l, smem);
    gsync(grid);
    phase_mix_norm(p, l);
    gsync(grid);
    gemm_bf16(WSH(YCATB), D, WSH(WOUTT) + (size_t)l * D * D, D, T, D, D, EpiResid{WSF(XCUR), modl + 2 * D}, smem_c);
    gsync(grid);
    phase_norm_mod(WSF(XCUR), p.norm2_g + l * D, modl + 4 * D, modl + 3 * D, WSF(H), WSH(HB));
    gsync(grid);
    gemm_bf16(WSH(HB), D, WSH(WQT) + (size_t)l * 2048 * D, D, T, 2048, D, EpiStoreBf16{WSH(QB), 2048}, smem_c);
    gsync(grid);
    phase_peer_topk2(p, l, smem_c);
    gsync(grid);
    phase_peer_expert(p, l);
    gsync(grid);
  }
  phase_final(p);
}

extern "C" void kernel_launch(void* const* d_in, const int* in_sizes, int n_in, void* d_out, int out_size, void* d_ws, size_t ws_size, hipStream_t stream) {
  static int grid_blocks = 0;
  if (!grid_blocks) {
    int dev = 0, cus = 0, per_cu = 0;
    hipGetDevice(&dev);
    hipDeviceGetAttribute(&cus, hipDeviceAttributeMultiprocessorCount, dev);
    hipOccupancyMaxActiveBlocksPerMultiprocessor(&per_cu, hymba_fwd, NTHR, 0);
    if (per_cu > 4) per_cu = 4;
    if (per_cu < 1) per_cu = 1;
    grid_blocks = cus * per_cu;
  }
  Params p;
  memset(&p, 0, sizeof(p));
  const float** ins = (const float**)&p;
  for (int i = 0; i < 23; ++i) ins[i] = (const float*)d_in[i];
  p.out = (float*)d_out;
  p.ws = (char*)d_ws;
  if (ws_size < WS_TOTAL2) fprintf(stderr, "workspace too small: %zu < %zu\n", ws_size, WS_TOTAL);
  void* args[] = {&p};
  hipError_t e = hipLaunchCooperativeKernel((void*)hymba_fwd, dim3(grid_blocks), dim3(NTHR), args, 0, stream);
  if (e != hipSuccess) fprintf(stderr, "cooperative launch failed: %s (grid %d)\n", hipGetErrorString(e), grid_blocks);
}
```

```cpp
#include <hip/hip_runtime.h>
#include <hip/hip_cooperative_groups.h>
#include <cstdio>
#include <cstdint>
#include <cstring>
namespace cg = cooperative_groups;

constexpr int D = 1024, NB = 2, S = 8192, T = NB * S, NL = 4;
constexpr int NIN = 2824;
constexpr int C_Z = 0, C_XBC = 512, C_DT = 1536, C_MQ = 1544, C_MK = 1800, C_MV = 2056, C_SQ = 2312, C_SK = 2568, C_SV = 2696;
constexpr int NTHR = 256;

struct Params {
  const float *x, *c, *ada_w, *ada_b, *norm1_g, *norm2_g, *w_in, *conv_w, *conv_b, *dt_bias, *a_log, *d_skip,
      *ssd_norm_g, *moba_norm_g, *swa_sinks, *swa_norm_g, *w_out, *peer_wq, *peer_k1, *peer_k2, *peer_u, *peer_v, *final_g;
  float* out;
  char* ws;
};
constexpr size_t al256(size_t x) { return (x + 255) & ~(size_t)255; }
constexpr size_t OFF_MOD = 0;
constexpr size_t OFF_KMEAN = OFF_MOD + al256((size_t)NL * 2 * 6 * D * 4);
constexpr size_t OFF_XCUR = OFF_KMEAN + al256((size_t)NB * 4 * 32 * 64 * 4);
constexpr size_t OFF_H = OFF_XCUR + al256((size_t)T * D * 4);
constexpr size_t OFF_PROJ = OFF_H + al256((size_t)T * D * 4);
constexpr size_t OFF_DTB = OFF_PROJ + al256((size_t)T * NIN * 4);
constexpr size_t OFF_ACS = OFF_DTB + al256((size_t)T * 8 * 4);
constexpr size_t OFF_YBUF = OFF_ACS + al256((size_t)T * 8 * 4);
constexpr size_t OFF_STATES = OFF_YBUF + al256((size_t)T * 512 * 4);
constexpr size_t OFF_YCAT = OFF_STATES + al256((size_t)NB * 64 * 8 * 64 * 128 * 4);
constexpr size_t OFF_EIDX = OFF_YCAT + al256((size_t)T * 1024 * 4);
constexpr size_t OFF_GVAL = OFF_EIDX + al256((size_t)T * 128 * 4);
constexpr int NINP = 2944;
constexpr size_t OFF_HB = OFF_GVAL + al256((size_t)T * 128 * 4);
constexpr size_t OFF_YCATB = OFF_HB + al256((size_t)T * D * 2);
constexpr size_t OFF_WINT = OFF_YCATB + al256((size_t)T * D * 2);
constexpr size_t OFF_WOUTT = OFF_WINT + al256((size_t)NL * NINP * D * 2);
constexpr size_t OFF_WQT = OFF_WOUTT + al256((size_t)NL * D * D * 2);
constexpr size_t OFF_UB = OFF_WQT + al256((size_t)NL * 2048 * D * 2);
constexpr size_t OFF_VB = OFF_UB + al256((size_t)NL * 16384 * D);
constexpr size_t OFF_K12B = OFF_VB + al256((size_t)NL * 16384 * D);
constexpr size_t WS_TOTAL = OFF_K12B + al256((size_t)NL * 2 * 128 * 128 * 2);
constexpr size_t OFF_MQK = WS_TOTAL;
constexpr size_t OFF_MVT = OFF_MQK + al256((size_t)T * 512 * 2);
constexpr size_t OFF_SQK = OFF_MVT + al256((size_t)T * 256 * 2);
constexpr size_t OFF_SVT = OFF_SQK + al256((size_t)T * 384 * 2);
constexpr size_t OFF_MSEL = OFF_SVT + al256((size_t)T * 128 * 2);
constexpr size_t OFF_MKT = OFF_MSEL + al256((size_t)T * 4 * 4);
constexpr size_t OFF_SKT = OFF_MKT + al256((size_t)T * 256 * 2);
constexpr size_t OFF_BCTOK = OFF_SKT + al256((size_t)T * 128 * 2);
constexpr size_t OFF_XBT = OFF_BCTOK + al256((size_t)T * 512 * 2);
constexpr size_t OFF_SINB = OFF_XBT + al256((size_t)NB * 768 * S * 2);
constexpr size_t OFF_SUV = OFF_SINB + al256((size_t)NB * 64 * 8 * 64 * 128 * 2);
constexpr size_t OFF_PARTO = OFF_SUV + al256((size_t)NL * 2 * 16384 * 4);
constexpr size_t OFF_PARTML = OFF_PARTO + al256((size_t)T * 16 * 64 * 4);
constexpr size_t OFF_BAR = OFF_PARTML + al256((size_t)T * 16 * 2 * 4);
constexpr size_t WS_TOTAL2 = OFF_BAR + 16384;
constexpr size_t OFF_QB = OFF_PROJ;
constexpr size_t OFF_PP = OFF_PROJ + ((size_t)64 << 20);
constexpr size_t OFF_ACT = OFF_PP + (size_t)8 * T * 128 * 4;
static_assert(OFF_ACT + (size_t)T * 128 * 4 <= OFF_PROJ + al256((size_t)T * NIN * 4), "PP/ACT must fit inside the proj region");
#define WSF(name) ((float*)(p.ws + OFF_##name))
#define WSI(name) ((int*)(p.ws + OFF_##name))
#define WSH(name) ((bf16_t*)(p.ws + OFF_##name))
typedef unsigned short bf16_t;
typedef short bf16x8 __attribute__((ext_vector_type(8)));
typedef short bf16x4 __attribute__((ext_vector_type(4)));
typedef float f32x4 __attribute__((ext_vector_type(4)));
typedef float f32x16 __attribute__((ext_vector_type(16)));
typedef __bf16 hwbf2 __attribute__((ext_vector_type(2)));
typedef float f32v2 __attribute__((ext_vector_type(2)));
__device__ __forceinline__ unsigned pack2bf(float lo, float hi) { const f32v2 v = {lo, hi}; const hwbf2 b = __builtin_convertvector(v, hwbf2); return *(const unsigned*)&b; }
__device__ __forceinline__ bf16_t f2bf(float f) { return (bf16_t)(pack2bf(f, 0.f) & 0xffffu); }
__device__ __forceinline__ float bflo(unsigned w) { return __uint_as_float(w << 16); }
__device__ __forceinline__ float bfhi(unsigned w) { return __uint_as_float(w & 0xffff0000u); }

__device__ __forceinline__ int opaque_tid() { int t = threadIdx.x; asm volatile("" : "+v"(t)); return t; }
#define TIDX opaque_tid()
__device__ __forceinline__ float siluf(float x) { return x / (1.f + expf(-x)); }
__device__ __forceinline__ float wave_sum(float v) {
#pragma unroll
  for (int o = 32; o > 0; o >>= 1) v += __shfl_xor(v, o);
  return v;
}
__device__ __forceinline__ void wave_argmax(float& v, int& i) {
#pragma unroll
  for (int o = 32; o > 0; o >>= 1) {
    float ov = __shfl_xor(v, o);
    int oi = __shfl_xor(i, o);
    if (ov > v || (ov == v && oi < i)) { v = ov; i = oi; }
  }
}

__device__ __forceinline__ void phase_mod(const Params& p, float* smem) {
  for (int i = TIDX; i < NB * D; i += NTHR) smem[i] = siluf(p.c[i]);
  __syncthreads();
  const int gtid = blockIdx.x * NTHR + TIDX, gsz = gridDim.x * NTHR;
  {
    float* red = smem + 2 * D;
    const int jl = TIDX & 63, ks = TIDX >> 6;
    for (int cb = blockIdx.x; cb < NL * 6 * D / 64; cb += gridDim.x) {
      const int idx = cb * 64 + jl, l = idx / (6 * D), j = idx % (6 * D);
      const float* w = p.ada_w + (size_t)l * D * 6 * D + j + (size_t)(ks * 256) * 6 * D;
      float a0 = 0.f, a1 = 0.f;
#pragma unroll 16
      for (int k = 0; k < 256; ++k) { const float wv = w[(size_t)k * 6 * D]; a0 += smem[ks * 256 + k] * wv; a1 += smem[D + ks * 256 + k] * wv; }
      __syncthreads();
      red[(ks * 64 + jl) * 2] = a0; red[(ks * 64 + jl) * 2 + 1] = a1;
      __syncthreads();
      if (ks == 0) {
        const float bb = p.ada_b[l * 6 * D + j];
        WSF(MOD)[(l * 2 + 0) * 6 * D + j] = red[jl * 2] + red[(64 + jl) * 2] + red[(128 + jl) * 2] + red[(192 + jl) * 2] + bb;
        WSF(MOD)[(l * 2 + 1) * 6 * D + j] = red[jl * 2 + 1] + red[(64 + jl) * 2 + 1] + red[(128 + jl) * 2 + 1] + red[(192 + jl) * 2 + 1] + bb;
      }
    }
  }
  const float4* xs = (const float4*)p.x; float4* xd = (float4*)WSF(XCUR);
  for (int i = gtid; i < T * D / 4; i += gsz) xd[i] = xs[i];
  __syncthreads();
}

#define LAS __attribute__((address_space(3)))
template <int RT16> __host__ __device__ __forceinline__ size_t gt_off(int row, int k) {
  const int sub = row >> 4, tile = sub / RT16, st = sub % RT16;
  int ob = (row & 15) * 64 + (k & 31) * 2;
  ob ^= ((ob >> 9) & 1) << 5;
  return ((size_t)(tile * 32 + (k >> 5)) * RT16 + st) * 512 + (size_t)(ob >> 1);
}
__device__ __forceinline__ void phase_norm_mod(const float* xin, const float* g, const float* sc, const float* sh, float* hout, bf16_t* hb) {
  const int wave = (blockIdx.x * NTHR + TIDX) >> 6, nw = gridDim.x * (NTHR / 64), lane = TIDX & 63;
  float4 g4[4];
#pragma unroll
  for (int i = 0; i < 4; ++i) g4[i] = *(const float4*)(g + (lane + 64 * i) * 4);
  for (int t0 = wave; t0 < T; t0 += 2 * nw) {
    const int t1 = (t0 + nw < T) ? t0 + nw : t0;
    float4 va[4], vb[4]; float sa = 0.f, sb = 0.f;
#pragma unroll
    for (int i = 0; i < 4; ++i) { va[i] = ((const float4*)(xin + (size_t)t0 * D))[lane + 64 * i]; vb[i] = ((const float4*)(xin + (size_t)t1 * D))[lane + 64 * i]; }
#pragma unroll
    for (int i = 0; i < 4; ++i) {
      sa += va[i].x * va[i].x + va[i].y * va[i].y + va[i].z * va[i].z + va[i].w * va[i].w;
      sb += vb[i].x * vb[i].x + vb[i].y * vb[i].y + vb[i].z * vb[i].z + vb[i].w * vb[i].w;
    }
#pragma unroll
    for (int of = 32; of > 0; of >>= 1) { sa += __shfl_xor(sa, of); sb += __shfl_xor(sb, of); }
    const float ia = rsqrtf(sa * (1.f / D) + 1e-5f), ib = rsqrtf(sb * (1.f / D) + 1e-5f);
#define NM_EMIT(tt, vv, inv_) do { const int b_ = (tt) / S; \
      _Pragma("unroll") for (int i = 0; i < 4; ++i) { \
        const int col = (lane + 64 * i) * 4; \
        const float4 sc4 = *(const float4*)(sc + b_ * 6 * D + col), sh4 = *(const float4*)(sh + b_ * 6 * D + col); \
        float4 o; \
        o.x = vv[i].x * (inv_) * g4[i].x * (1.f + sc4.x) + sh4.x; \
        o.y = vv[i].y * (inv_) * g4[i].y * (1.f + sc4.y) + sh4.y; \
        o.z = vv[i].z * (inv_) * g4[i].z * (1.f + sc4.z) + sh4.z; \
        o.w = vv[i].w * (inv_) * g4[i].w * (1.f + sc4.w) + sh4.w; \
        if (hout) ((float4*)(hout + (size_t)(tt) * D))[lane + 64 * i] = o; \
        *(uint2*)(hb + gt_off<16>((tt), col)) = make_uint2(pack2bf(o.x, o.y), pack2bf(o.z, o.w)); \
      } } while (0)
    NM_EMIT(t0, va, ia);
    if (t1 != t0) NM_EMIT(t1, vb, ib);
#undef NM_EMIT
  }
}

__device__ __forceinline__ void transpose_cvt(const float* __restrict__ W, int K, int N, int Npad, bf16_t* __restrict__ Bt, float* smem) {
  float (*tile)[65] = (float (*)[65])smem;
  const int tk = K / 64, tn = Npad / 64, tid = TIDX;
  for (int t = blockIdx.x; t < tk * tn; t += gridDim.x) {
    const int k0 = (t / tn) * 64, n0 = (t % tn) * 64;
    __syncthreads();
#pragma unroll
    for (int r = 0; r < 16; ++r) {
      const int k = r * 4 + (tid >> 6), n = tid & 63;
      tile[k][n] = (n0 + n < N) ? W[(size_t)(k0 + k) * N + n0 + n] : 0.f;
    }
    __syncthreads();
#pragma unroll
    for (int r = 0; r < 16; ++r) {
      const int n = r * 4 + (tid >> 6), k = tid & 63;
      Bt[gt_off<8>(n0 + n, k0 + k)] = f2bf(tile[k][n]);
    }
  }
  __syncthreads();
}
__device__ __forceinline__ void phase_prologue_weights(const Params& p, float* smem) {
  for (int l = 0; l < NL; ++l) {
    transpose_cvt(p.w_in + (size_t)l * D * NIN, D, NIN, NINP, WSH(WINT) + (size_t)l * NINP * D, smem);
    transpose_cvt(p.w_out + (size_t)l * D * D, D, D, D, WSH(WOUTT) + (size_t)l * D * D, smem);
    transpose_cvt(p.peer_wq + (size_t)l * D * 2048, D, 2048, 2048, WSH(WQT) + (size_t)l * 2048 * D, smem);
  }
  const int gtid = blockIdx.x * NTHR + TIDX, gsz = gridDim.x * NTHR;
  for (int i = gtid; i < NL * 2 * 128 * 128; i += gsz) {
    const int l = i / 32768, r = i % 32768;
    WSH(K12B)[i] = f2bf(r < 16384 ? p.peer_k1[l * 16384 + r] : p.peer_k2[l * 16384 + r - 16384]);
  }
  {
    const int lane = TIDX & 63, gw = (blockIdx.x * NTHR + TIDX) >> 6, nw = gridDim.x * (NTHR / 64);
    for (int row = gw; row < 2 * NL * 16384; row += nw) {
      const int which = row / (NL * 16384), r = row % (NL * 16384);
      const float4* src4 = (const float4*)((which ? p.peer_v : p.peer_u) + (size_t)r * D) + lane * 4;
      const float4 a = src4[0], b = src4[1], c = src4[2], d = src4[3];
      float m = fmaxf(fmaxf(fmaxf(fabsf(a.x), fabsf(a.y)), fmaxf(fabsf(a.z), fabsf(a.w))), fmaxf(fmaxf(fabsf(b.x), fabsf(b.y)), fmaxf(fabsf(b.z), fabsf(b.w))));
      m = fmaxf(m, fmaxf(fmaxf(fmaxf(fabsf(c.x), fabsf(c.y)), fmaxf(fabsf(c.z), fabsf(c.w))), fmaxf(fmaxf(fabsf(d.x), fabsf(d.y)), fmaxf(fabsf(d.z), fabsf(d.w)))));
#pragma unroll
      for (int o = 32; o > 0; o >>= 1) m = fmaxf(m, __shfl_xor(m, o));
      const float sc = m > 0.f ? m * (1.f / 240.f) : 1.f, inv = 1.f / sc;
      int w0 = 0, w1 = 0, w2 = 0, w3 = 0;
      w0 = __builtin_amdgcn_cvt_pk_fp8_f32(a.x * inv, a.y * inv, w0, false); w0 = __builtin_amdgcn_cvt_pk_fp8_f32(a.z * inv, a.w * inv, w0, true);
      w1 = __builtin_amdgcn_cvt_pk_fp8_f32(b.x * inv, b.y * inv, w1, false); w1 = __builtin_amdgcn_cvt_pk_fp8_f32(b.z * inv, b.w * inv, w1, true);
      w2 = __builtin_amdgcn_cvt_pk_fp8_f32(c.x * inv, c.y * inv, w2, false); w2 = __builtin_amdgcn_cvt_pk_fp8_f32(c.z * inv, c.w * inv, w2, true);
      w3 = __builtin_amdgcn_cvt_pk_fp8_f32(d.x * inv, d.y * inv, w3, false); w3 = __builtin_amdgcn_cvt_pk_fp8_f32(d.z * inv, d.w * inv, w3, true);
      {
        const int l_ = r / 16384, e_ = r % 16384;
        *(uint4*)(p.ws + (which ? OFF_VB : OFF_UB) + (((size_t)(l_ * 8 + (lane >> 3)) * 16384 + e_) * 128 + (lane & 7) * 16)) = make_uint4((unsigned)w0, (unsigned)w1, (unsigned)w2, (unsigned)w3);
      }
      if (lane == 0) {
        const int l = r / 16384, e = r % 16384;
        WSF(SUV)[(l * 2 + which) * 16384 + e] = sc;
      }
    }
  }
}

struct EpiStoreF32 {
  float* C; int ldc, N;
  __device__ __forceinline__ void operator()(int m, int n, f32x4 v) const { if (n < N) *(f32x4*)(C + (size_t)m * ldc + n) = v; }
};

__host__ __device__ __forceinline__ size_t ktile_off(int bh, int s, int d) {
  return ((((size_t)bh * 128 + (s >> 6)) * 2 + ((s >> 5) & 1)) * 4 + (d >> 4)) * 512 + (size_t)(((s & 31) + 32 * ((d >> 3) & 1)) * 8 + (d & 7));
}
__host__ __device__ __forceinline__ size_t vtile_off(int bh, int d, int s) {
  const int kk = s & 63, ks = ((kk >> 5) << 1) | ((kk >> 4) & 1), piece = (kk >> 3) & 1, h = (kk >> 2) & 1;
  return ((((((size_t)bh * 128 + (s >> 6)) * 4 + ks) * 2 + piece) * 2 + (d >> 5)) * 64 + ((d & 31) + 32 * h)) * 4 + (kk & 3);
}
struct EpiInProj {
  float* C; bf16_t *mqk, *mkt, *mvt, *sqk, *skt, *svt;
  __device__ __forceinline__ void operator()(int m, int n, f32x4 v) const {
    if (n >= NIN) return;
    if (n < C_MV) *(f32x4*)(C + (size_t)m * NIN + n) = v;
    if (n < C_MQ) return;
    const int b = m / S, s = m & (S - 1);
    const uint2 pk = make_uint2(pack2bf(v[0], v[1]), pack2bf(v[2], v[3]));
    if (n < C_MK) { *(uint2*)(mqk + (size_t)m * 512 + (n - C_MQ)) = pk; }
    else if (n < C_MV) { const int c = n - C_MK; *(uint2*)(mkt + ktile_off(b * 4 + (c >> 6), s, c & 63)) = pk; }
    else if (n < C_SQ) { const int c = n - C_MV, bh = b * 4 + (c >> 6), d = c & 63;
      mvt[vtile_off(bh, d, s)] = (bf16_t)(pk.x & 0xffff); mvt[vtile_off(bh, d + 1, s)] = (bf16_t)(pk.x >> 16); mvt[vtile_off(bh, d + 2, s)] = (bf16_t)(pk.y & 0xffff); mvt[vtile_off(bh, d + 3, s)] = (bf16_t)(pk.y >> 16); }
    else if (n < C_SK) { *(uint2*)(sqk + (size_t)m * 384 + (n - C_SQ)) = pk; }
    else if (n < C_SV) { const int c = n - C_SK; *(uint2*)(skt + ktile_off(b * 2 + (c >> 6), s, c & 63)) = pk; }
    else { const int c = n - C_SV, bh = b * 2 + (c >> 6), d = c & 63;
      svt[vtile_off(bh, d, s)] = (bf16_t)(pk.x & 0xffff); svt[vtile_off(bh, d + 1, s)] = (bf16_t)(pk.x >> 16); svt[vtile_off(bh, d + 2, s)] = (bf16_t)(pk.y & 0xffff); svt[vtile_off(bh, d + 3, s)] = (bf16_t)(pk.y >> 16); }
  }
};
struct EpiStoreBf16 {
  bf16_t* C; int ldc;
  __device__ __forceinline__ void operator()(int m, int n, f32x4 v) const { *(uint2*)(C + (size_t)m * ldc + n) = make_uint2(pack2bf(v[0], v[1]), pack2bf(v[2], v[3])); }
};
struct EpiResid {
  float* X; const float* gate;
  __device__ __forceinline__ void operator()(int m, int n, f32x4 v) const {
    const f32x4 g = *(const f32x4*)(gate + (m / S) * 6 * D + n);
    f32x4* xp = (f32x4*)(X + (size_t)m * D + n);
    f32x4 o = *xp; o += g * v; *xp = o;
  }
};
__device__ __forceinline__ void glds16(const void* gsrc, unsigned lds_dst) {
  unsigned keep;
  lds_dst = __builtin_amdgcn_readfirstlane(lds_dst);
  asm volatile("s_mov_b32 %0, m0\n\ts_mov_b32 m0, %2\n\ts_nop 0\n\tglobal_load_lds_dwordx4 %1, off\n\ts_mov_b32 m0, %0" : "=&s"(keep) : "v"(gsrc), "s"(lds_dst) : "memory");
}
template <int NPAD, class Epi>
__device__ __forceinline__ void gemm_bf16(const bf16_t* __restrict__ A, const bf16_t* __restrict__ Bt, const Epi epi, char* smem) {
  const int tid = TIDX, lane = tid & 63, wid = tid >> 6, wr = wid >> 1, wc = wid & 1;
  constexpr int tilesN = NPAD / 128, tilesM = T / 256, ntiles = tilesM * tilesN, nk = D / 32, nig = 8 * tilesN;
  static_assert(tilesM % 8 == 0 && ntiles % 8 == 0 && nk % 2 == 0, "raster");
  int q0, qstep, nmy;
  { const int G = (int)gridDim.x, b = (int)blockIdx.x;
    if ((G & 15) == 0) { const int R = G >> 3, x = b & 7, r = b >> 3, pos = (r % (R >> 1)) * 2 + r / (R >> 1); constexpr int per = ntiles / 8;
      q0 = x * per + pos; qstep = R; nmy = (pos < per) ? (per - 1 - pos) / R + 1 : 0; }
    else { q0 = b; qstep = G; nmy = (b < ntiles) ? (ntiles - 1 - b) / G + 1 : 0; } }
  const int total = nmy * nk;
  if (total == 0) return;
  const unsigned lds0 = __builtin_amdgcn_readfirstlane((unsigned)(size_t)(LAS char*)smem);
  int fo = (lane & 15) * 64 + (lane >> 4) * 16;
  fo ^= ((fo >> 9) & 1) << 5;
  const int fa0 = wr * 8192 + fo, fb0 = 16384 + wc * 4096 + fo;
  f32x4 acc[8][4];
#pragma unroll
  for (int i = 0; i < 8; ++i)
#pragma unroll
    for (int j = 0; j < 4; ++j) acc[i][j] = (f32x4){0.f, 0.f, 0.f, 0.f};
#define TILEQ(s) const int q_ = q0 + ((s) / nk) * qstep, gid_ = q_ / nig, rem_ = q_ - gid_ * nig, tm_ = gid_ * 8 + (rem_ & 7), tn_ = rem_ >> 3;
#define GSTAGE(buf, s) do { TILEQ(s) \
      const bf16_t* Ag = A + (size_t)(tm_ * 32 + ((s) % nk)) * 8192 + wid * 2048 + lane * 8; \
      const bf16_t* Bg = Bt + (size_t)(tn_ * 32 + ((s) % nk)) * 4096 + wid * 1024 + lane * 8; \
      const unsigned la_ = lds0 + (buf) + wid * 4096, lb_ = lds0 + (buf) + 16384 + wid * 2048; \
      glds16(Ag, la_); glds16(Ag + 512, la_ + 1024); glds16(Ag + 1024, la_ + 2048); glds16(Ag + 1536, la_ + 3072); \
      glds16(Bg, lb_); glds16(Bg + 512, lb_ + 1024); } while (0)
#define MM(mi, ni, a, b) acc[mi][ni] = __builtin_amdgcn_mfma_f32_16x16x32_bf16(b, a, acc[mi][ni], 0, 0, 0)
#define MROW(mi, af) do { MM(mi, 0, af, bf0); MM(mi, 1, af, bf1); MM(mi, 2, af, bf2); MM(mi, 3, af, bf3); } while (0)
#define AFR(mi, cur) *(const bf16x8*)(smem + (cur) + fa0 + (mi) * 1024)
#define SB __builtin_amdgcn_sched_barrier(0)
#define COMPUTE(cur) do { \
        const bf16x8 bf0 = *(const bf16x8*)(smem + (cur) + fb0); \
        const bf16x8 bf1 = *(const bf16x8*)(smem + (cur) + fb0 + 1024); \
        const bf16x8 bf2 = *(const bf16x8*)(smem + (cur) + fb0 + 2048); \
        const bf16x8 bf3 = *(const bf16x8*)(smem + (cur) + fb0 + 3072); \
        const bf16x8 af0 = AFR(0, cur), af1 = AFR(1, cur); SB; \
        const bf16x8 af2 = AFR(2, cur); MROW(0, af0); SB; \
        const bf16x8 af3 = AFR(3, cur); MROW(1, af1); SB; \
        const bf16x8 af4 = AFR(4, cur); MROW(2, af2); SB; \
        const bf16x8 af5 = AFR(5, cur); MROW(3, af3); SB; \
        const bf16x8 af6 = AFR(6, cur); MROW(4, af4); SB; \
        const bf16x8 af7 = AFR(7, cur); MROW(5, af5); SB; \
        MROW(6, af6); MROW(7, af7); SB; } while (0)
  __syncthreads();
  GSTAGE(0, 0);
  GSTAGE(24576, 1);
  int cur = 0, prev = 49152;
#pragma unroll 1
  for (int s = 0; s < total; ++s) {
    if (s + 1 < total) asm volatile("s_waitcnt vmcnt(6)" ::: "memory"); else asm volatile("s_waitcnt vmcnt(0)" ::: "memory");
    asm volatile("s_waitcnt lgkmcnt(0)\n\ts_barrier" ::: "memory");
    {
      const bool st = s + 2 < total;
      TILEQ(s + 2)
      const bf16_t* Ag = A + (size_t)(tm_ * 32 + ((s + 2) % nk)) * 8192 + wid * 2048 + lane * 8;
      const bf16_t* Bg = Bt + (size_t)(tn_ * 32 + ((s + 2) % nk)) * 4096 + wid * 1024 + lane * 8;
      const unsigned la_ = lds0 + prev + wid * 4096, lb_ = lds0 + prev + 16384 + wid * 2048;
      const bf16x8 bf0 = *(const bf16x8*)(smem + cur + fb0);
      const bf16x8 bf1 = *(const bf16x8*)(smem + cur + fb0 + 1024);
      const bf16x8 bf2 = *(const bf16x8*)(smem + cur + fb0 + 2048);
      const bf16x8 bf3 = *(const bf16x8*)(smem + cur + fb0 + 3072);
      const bf16x8 af0 = AFR(0, cur), af1 = AFR(1, cur); SB;
      const bf16x8 af2 = AFR(2, cur); MROW(0, af0); if (st) glds16(Ag, la_); SB;
      const bf16x8 af3 = AFR(3, cur); MROW(1, af1); if (st) glds16(Ag + 512, la_ + 1024); SB;
      const bf16x8 af4 = AFR(4, cur); MROW(2, af2); if (st) glds16(Ag + 1024, la_ + 2048); SB;
      const bf16x8 af5 = AFR(5, cur); MROW(3, af3); if (st) glds16(Ag + 1536, la_ + 3072); SB;
      const bf16x8 af6 = AFR(6, cur); MROW(4, af4); if (st) glds16(Bg, lb_); SB;
      const bf16x8 af7 = AFR(7, cur); MROW(5, af5); if (st) glds16(Bg + 512, lb_ + 1024); SB;
      MROW(6, af6); MROW(7, af7); SB;
    }
    if (s % nk == nk - 1) {
      TILEQ(s) const int tm = tm_, tn = tn_;
#pragma unroll
      for (int mi = 0; mi < 8; ++mi)
#pragma unroll
        for (int ni = 0; ni < 4; ++ni) {
          epi(tm * 256 + wr * 128 + mi * 16 + (lane & 15), tn * 128 + wc * 64 + ni * 16 + (lane >> 4) * 4, acc[mi][ni]);
          acc[mi][ni] = (f32x4){0.f, 0.f, 0.f, 0.f};
        }
    }
    prev = cur; cur = (cur == 49152) ? 0 : cur + 24576;
  }
  __syncthreads();
#undef TILEQ
#undef GSTAGE
#undef MM
#undef MROW
#undef AFR
#undef SB
#undef COMPUTE
}


__host__ __device__ __forceinline__ size_t bct_off(int t, int cc) {
  const int n = cc & 127;
  return ((((size_t)(t >> 5) * 4 + (cc >> 7)) * 8 + (n >> 4)) * 64 + ((t & 31) + 32 * ((n >> 3) & 1))) * 8 + (n & 7);
}
__host__ __device__ __forceinline__ size_t xbt_off(int b, int ch, int s) {
  const int kk = s & 127, rem = kk & 31;
  size_t o = (size_t)(b * 64 + (s >> 7));
  o = o * 24 + (ch >> 5);
  o = o * 4 + (kk >> 5);
  o = o * 2 + (rem >> 4);
  o = o * 2 + ((rem >> 3) & 1);
  o = o * 64 + ((ch & 31) + 32 * ((rem >> 2) & 1));
  return o * 4 + (rem & 3);
}
__device__ __forceinline__ void phase_ssd_conv(const Params& p, int l, float* smem) {
  const int tid = TIDX, lane = tid & 63, wv = tid >> 6;
  float (*xin)[64] = (float (*)[64])smem;
  float (*ot)[65] = (float (*)[65])(smem + 67 * 64);
  const float* cw = p.conv_w + l * 4 * 1024; const float* cbv = p.conv_b + l * 1024;
  float4 r0, r1, r2, r3, r4;
#define CONV_ONE(R, k, tl) do { const int i_ = tid + (k) * NTHR, row_ = i_ >> 4, c4_ = (i_ & 15) * 4; \
      const int t0_ = ((tl) >> 4) * 64, ch0_ = ((tl) & 15) * 64, s0_ = t0_ & (S - 1); \
      R = make_float4(0.f, 0.f, 0.f, 0.f); \
      if (i_ < 67 * 16 && s0_ + row_ - 3 >= 0) R = *(const float4*)(WSF(PROJ) + (size_t)(t0_ + row_ - 3) * NIN + C_XBC + ch0_ + c4_); } while (0)
#define CONV_FETCH(tl) do { CONV_ONE(r0, 0, tl); CONV_ONE(r1, 1, tl); CONV_ONE(r2, 2, tl); CONV_ONE(r3, 3, tl); CONV_ONE(r4, 4, tl); } while (0)
#define CONV_PUT(R, k) do { const int i_ = tid + (k) * NTHR; if (i_ < 67 * 16) *(float4*)&xin[i_ >> 4][(i_ & 15) * 4] = R; } while (0)
  if ((int)blockIdx.x < 256 * 16) CONV_FETCH((int)blockIdx.x);
  for (int tile = blockIdx.x; tile < 256 * 16; tile += gridDim.x) {
    const int tt = tile >> 4, ct = tile & 15, t0 = tt * 64, ch0 = ct * 64, s0 = t0 & (S - 1), b = t0 / S;
    __syncthreads();
    CONV_PUT(r0, 0); CONV_PUT(r1, 1); CONV_PUT(r2, 2); CONV_PUT(r3, 3); CONV_PUT(r4, 4);
    if (tile + (int)gridDim.x < 256 * 16) CONV_FETCH(tile + (int)gridDim.x);
    __syncthreads();
    {
      const int ch = ch0 + lane;
      const float w0 = cw[ch], w1 = cw[1024 + ch], w2 = cw[2048 + ch], w3 = cw[3072 + ch], bb = cbv[ch];
      float x0 = xin[wv * 16 + 0][lane], x1 = xin[wv * 16 + 1][lane], x2 = xin[wv * 16 + 2][lane];
#pragma unroll
      for (int i = 0; i < 16; ++i) {
        const int tok = wv * 16 + i;
        const float x3 = xin[tok + 3][lane];
        const float v = siluf(bb + w0 * x0 + w1 * x1 + w2 * x2 + w3 * x3);
        x0 = x1; x1 = x2; x2 = x3;
        ot[tok][lane] = v;
      }
    }
    __syncthreads();
    if (ch0 >= 512) {
#pragma unroll
      for (int i = 0; i < 2; ++i) {
        const int it = tid + i * NTHR, tok = it & 63, n8 = (it >> 6) * 8;
        const float* o8 = &ot[tok][n8];
        *(uint4*)(WSH(BCTOK) + (size_t)(t0 + tok) * 512 + (ch0 - 512 + n8)) = make_uint4(pack2bf(o8[0], o8[1]), pack2bf(o8[2], o8[3]), pack2bf(o8[4], o8[5]), pack2bf(o8[6], o8[7]));
      }
    }
    if (ch0 < 768) {
#pragma unroll
      for (int i = 0; i < 4; ++i) {
        const int it = tid + i * NTHR, chl = it & 63, tk4 = (it >> 6) * 4;
        *(uint2*)(WSH(XBT) + xbt_off(b, ch0 + chl, s0 + tk4)) = make_uint2(pack2bf(ot[tk4][chl], ot[tk4 + 1][chl]), pack2bf(ot[tk4 + 2][chl], ot[tk4 + 3][chl]));
      }
    }
  }
#undef CONV_ONE
#undef CONV_FETCH
#undef CONV_PUT
  __syncthreads();
  const int gw = (blockIdx.x * NTHR + tid) >> 6, nw = gridDim.x * (NTHR / 64);
  for (int item = gw; item < NB * 64 * 8; item += nw) {
    const int hh = item & 7, bc = item >> 3;
    const float ah = -expf(p.a_log[l * 8 + hh]), bias = p.dt_bias[l * 8 + hh];
    float dtv[2], av[2];
#pragma unroll
    for (int i = 0; i < 2; ++i) {
      const int t = bc * 128 + i * 64 + lane;
      const float v = WSF(PROJ)[(size_t)t * NIN + C_DT + hh] + bias;
      dtv[i] = v > 20.f ? v : log1pf(expf(v));
      av[i] = dtv[i] * ah;
    }
#pragma unroll
    for (int o = 1; o < 64; o <<= 1) {
      const float u0 = __shfl_up(av[0], o), u1 = __shfl_up(av[1], o);
      if (lane >= o) { av[0] += u0; av[1] += u1; }
    }
    av[1] += __shfl(av[0], 63);
#pragma unroll
    for (int i = 0; i < 2; ++i) { const int t = bc * 128 + i * 64 + lane; WSF(DTB)[t * 8 + hh] = dtv[i]; WSF(ACS)[t * 8 + hh] = av[i]; }
  }
  {
    float* red = smem;
    for (int item = blockIdx.x; item < NB * 32 * 4; item += gridDim.x) {
      const int hh = item & 3, n = (item >> 2) & 31, b = item >> 7;
      const float* kp = WSF(PROJ) + (size_t)(b * S + n * 256 + wv * 64) * NIN + C_MK + hh * 64 + lane;
      float s = 0.f;
#pragma unroll 16
      for (int j = 0; j < 64; ++j) s += kp[(size_t)j * NIN];
      __syncthreads();
      red[wv * 64 + lane] = s;
      __syncthreads();
      if (wv == 0) WSF(KMEAN)[((b * 4 + hh) * 32 + n) * 64 + lane] = (red[lane] + red[64 + lane] + red[128 + lane] + red[192 + lane]) * (1.f / 256.f);
    }
  }
  __syncthreads();
}

__device__ __forceinline__ bf16x8 scale_bf8(const bf16x8 v, const float* w) {
  bf16x8 r;
#pragma unroll
  for (int j = 0; j < 4; ++j) {
    const unsigned lo = (unsigned short)v[2 * j], hi = (unsigned short)v[2 * j + 1];
    const unsigned pk = pack2bf(__uint_as_float(lo << 16) * w[2 * j], __uint_as_float(hi << 16) * w[2 * j + 1]);
    r[2 * j] = (short)(pk & 0xffff); r[2 * j + 1] = (short)(pk >> 16);
  }
  return r;
}
__device__ __forceinline__ void phase_ssd_states(const Params& p, float* smem) {
  const int tid = TIDX, lane = tid & 63, wv = tid >> 6, h = lane >> 5, r31 = lane & 31;
  float* wl = smem;
  for (int item = blockIdx.x; item < NB * 64 * 8; item += gridDim.x) {
    const int hh = item & 7, bc = item >> 3, b = bc >> 6, c = bc & 63, g = hh >> 2, t0 = bc * 128;
    __syncthreads();
    if (tid < 128) wl[tid] = expf(WSF(ACS)[(t0 + 127) * 8 + hh] - WSF(ACS)[(t0 + tid) * 8 + hh]) * WSF(DTB)[(t0 + tid) * 8 + hh];
    __syncthreads();
    const bf16_t* xa0 = WSH(XBT) + xbt_off(b, hh * 64, c * 128) + lane * 4;
    const bf16_t* xa1 = WSH(XBT) + xbt_off(b, hh * 64 + 32, c * 128) + lane * 4;
    const bf16_t* bb = WSH(XBT) + xbt_off(b, 512 + g * 128 + wv * 32, c * 128) + lane * 4;
    f32x16 acc0, acc1;
#pragma unroll
    for (int r = 0; r < 16; ++r) { acc0[r] = 0.f; acc1[r] = 0.f; }
#pragma unroll
    for (int ks = 0; ks < 8; ++ks) {
      const bf16x4 p0 = *(const bf16x4*)(xa0 + ks * 512), p1 = *(const bf16x4*)(xa0 + ks * 512 + 256);
      const bf16x4 q0 = *(const bf16x4*)(xa1 + ks * 512), q1 = *(const bf16x4*)(xa1 + ks * 512 + 256);
      const bf16x4 b0 = *(const bf16x4*)(bb + ks * 512), b1 = *(const bf16x4*)(bb + ks * 512 + 256);
      const bf16x8 a0 = (bf16x8){p0[0], p0[1], p0[2], p0[3], p1[0], p1[1], p1[2], p1[3]};
      const bf16x8 a1 = (bf16x8){q0[0], q0[1], q0[2], q0[3], q1[0], q1[1], q1[2], q1[3]};
      const float4 wlo = *(const float4*)(wl + 16 * ks + 4 * h), whi = *(const float4*)(wl + 16 * ks + 8 + 4 * h);
      const float w8[8] = {wlo.x, wlo.y, wlo.z, wlo.w, whi.x, whi.y, whi.z, whi.w};
      const bf16x8 bq = scale_bf8((bf16x8){b0[0], b0[1], b0[2], b0[3], b1[0], b1[1], b1[2], b1[3]}, w8);
      acc0 = __builtin_amdgcn_mfma_f32_32x32x16_bf16(a0, bq, acc0, 0, 0, 0);
      acc1 = __builtin_amdgcn_mfma_f32_32x32x16_bf16(a1, bq, acc1, 0, 0, 0);
    }
    float* sp = WSF(STATES) + ((size_t)item * 64) * 128 + wv * 32 + r31;
#pragma unroll
    for (int r = 0; r < 16; ++r) {
      const int pr = (r & 3) + 8 * (r >> 2) + 4 * h;
      sp[(size_t)pr * 128] = acc0[r]; sp[(size_t)(32 + pr) * 128] = acc1[r];
    }
  }
  __syncthreads();
}

__device__ __forceinline__ void phase_ssd_scan(const Params& p) {
  const int gtid = blockIdx.x * NTHR + TIDX, gsz = gridDim.x * NTHR;
  for (int idx = gtid; idx < NB * 8 * 64 * 128; idx += gsz) {
    const int pn = idx & 8191, hh = (idx >> 13) & 7, b = idx >> 16;
    float Sv = 0.f;
#pragma unroll 1
    for (int c0 = 0; c0 < 64; c0 += 8) {
      float tmp[8], dec[8];
#pragma unroll
      for (int i = 0; i < 8; ++i) {
        tmp[i] = WSF(STATES)[((size_t)((b * 64 + c0 + i) * 8 + hh)) * 8192 + pn];
        dec[i] = WSF(ACS)[(b * S + (c0 + i) * 128 + 127) * 8 + hh];
      }
#pragma unroll
      for (int i = 0; i < 8; ++i) {
        WSH(SINB)[((size_t)((b * 64 + c0 + i) * 8 + hh)) * 8192 + pn] = f2bf(Sv);
        Sv = expf(dec[i]) * Sv + tmp[i];
      }
    }
  }
}

__device__ __forceinline__ void phase_ssd_y(const Params& p, int l, float* smem) {
  const int tid = TIDX, lane = tid & 63, wv = tid >> 6, h = lane >> 5, r31 = lane & 31;
  float* acs_s = smem; float* dt_s = smem + 128;
  for (int item = blockIdx.x; item < NB * 64 * 8; item += gridDim.x) {
    const int hh = item & 7, bc = item >> 3, b = bc >> 6, c = bc & 63, g = hh >> 2, t0 = bc * 128;
    __syncthreads();
    if (tid < 128) { acs_s[tid] = WSF(ACS)[(t0 + tid) * 8 + hh]; dt_s[tid] = WSF(DTB)[(t0 + tid) * 8 + hh]; }
    __syncthreads();
    const float dsk = p.d_skip[l * 8 + hh];
    const float acs_l = acs_s[wv * 32 + r31];
    bf16x8 cf[8];
    {
      const bf16_t* cp = WSH(BCTOK) + (size_t)(t0 + wv * 32 + r31) * 512 + 256 + g * 128 + 8 * h;
#pragma unroll
      for (int ks = 0; ks < 8; ++ks) cf[ks] = *(const bf16x8*)(cp + 16 * ks);
    }
    f32x16 y0, y1;
#pragma unroll
    for (int r = 0; r < 16; ++r) { y0[r] = 0.f; y1[r] = 0.f; }
    const bf16_t* xrow = WSH(XBT) + xbt_off(b, hh * 64, c * 128) + lane * 4;
    for (int st = 0; st <= wv; ++st) {
      f32x16 G;
#pragma unroll
      for (int r = 0; r < 16; ++r) G[r] = 0.f;
      const bf16_t* bp = WSH(BCTOK) + (size_t)(t0 + st * 32 + r31) * 512 + g * 128 + 8 * h;
#pragma unroll
      for (int ks = 0; ks < 8; ++ks) G = __builtin_amdgcn_mfma_f32_32x32x16_bf16(*(const bf16x8*)(bp + 16 * ks), cf[ks], G, 0, 0, 0);
      const bool diag = (st == wv);
#pragma unroll
      for (int r = 0; r < 16; ++r) {
        const int sl = (r & 3) + 8 * (r >> 2) + 4 * h, s = st * 32 + sl;
        float v = G[r] * __expf(acs_l - acs_s[s]) * dt_s[s];
        if (diag) { v = (sl <= r31) ? v : 0.f; if (sl == r31) v += dsk; }
        G[r] = v;
      }
      bf16x8 mf[2];
#pragma unroll
      for (int q = 0; q < 2; ++q) {
        unsigned w4[4];
#pragma unroll
        for (int j = 0; j < 4; ++j) w4[j] = pack2bf(G[q * 8 + 2 * j], G[q * 8 + 2 * j + 1]);
        mf[q] = (bf16x8){(short)(w4[0] & 0xffff), (short)(w4[0] >> 16), (short)(w4[1] & 0xffff), (short)(w4[1] >> 16), (short)(w4[2] & 0xffff), (short)(w4[2] >> 16), (short)(w4[3] & 0xffff), (short)(w4[3] >> 16)};
      }
#pragma unroll
      for (int q = 0; q < 2; ++q) {
        const bf16_t* xp = xrow + (st * 2 + q) * 512;
        const bf16x4 a0 = *(const bf16x4*)xp, a1 = *(const bf16x4*)(xp + 256);
        const bf16x4 b0 = *(const bf16x4*)(xp + 4096), b1 = *(const bf16x4*)(xp + 4096 + 256);
        const bf16x8 xa0 = (bf16x8){a0[0], a0[1], a0[2], a0[3], a1[0], a1[1], a1[2], a1[3]};
        const bf16x8 xa1 = (bf16x8){b0[0], b0[1], b0[2], b0[3], b1[0], b1[1], b1[2], b1[3]};
        y0 = __builtin_amdgcn_mfma_f32_32x32x16_bf16(xa0, mf[q], y0, 0, 0, 0);
        y1 = __builtin_amdgcn_mfma_f32_32x32x16_bf16(xa1, mf[q], y1, 0, 0, 0);
      }
    }
    f32x16 z0, z1;
#pragma unroll
    for (int r = 0; r < 16; ++r) { z0[r] = 0.f; z1[r] = 0.f; }
    {
      const bf16_t* sp = WSH(SINB) + ((size_t)item * 64 + r31) * 128 + 8 * h;
#pragma unroll
      for (int ks = 0; ks < 8; ++ks) {
        z0 = __builtin_amdgcn_mfma_f32_32x32x16_bf16(*(const bf16x8*)(sp + 16 * ks), cf[ks], z0, 0, 0, 0);
        z1 = __builtin_amdgcn_mfma_f32_32x32x16_bf16(*(const bf16x8*)(sp + (size_t)32 * 128 + 16 * ks), cf[ks], z1, 0, 0, 0);
      }
    }
    const float eal = __expf(acs_l);
    float* yp = WSF(YBUF) + (size_t)(t0 + wv * 32 + r31) * 512 + hh * 64 + 4 * h;
#pragma unroll
    for (int gq = 0; gq < 4; ++gq) {
      *(float4*)(yp + gq * 8) = make_float4(y0[gq * 4 + 0] + eal * z0[gq * 4 + 0], y0[gq * 4 + 1] + eal * z0[gq * 4 + 1], y0[gq * 4 + 2] + eal * z0[gq * 4 + 2], y0[gq * 4 + 3] + eal * z0[gq * 4 + 3]);
      *(float4*)(yp + 32 + gq * 8) = make_float4(y1[gq * 4 + 0] + eal * z1[gq * 4 + 0], y1[gq * 4 + 1] + eal * z1[gq * 4 + 1], y1[gq * 4 + 2] + eal * z1[gq * 4 + 2], y1[gq * 4 + 3] + eal * z1[gq * 4 + 3]);
    }
  }
  __syncthreads();
}


__device__ __forceinline__ void phase_mix_norm(const Params& p, int l) {
  const int wave = (blockIdx.x * NTHR + TIDX) >> 6, nw = gridDim.x * (NTHR / 64), lane = TIDX & 63;
  const float4 gs0 = *(const float4*)(p.ssd_norm_g + l * 512 + lane * 4), gs1 = *(const float4*)(p.ssd_norm_g + l * 512 + 256 + lane * 4);
  const float4 gm = *(const float4*)(p.moba_norm_g + l * 256 + lane * 4), gw = *(const float4*)(p.swa_norm_g + l * 256 + lane * 4);
  const int hh = lane >> 4, d4 = (lane & 15) * 4;
  for (int t = wave; t < T; t += nw) {
    const float4 y0 = *(const float4*)(WSF(YBUF) + (size_t)t * 512 + lane * 4), y1 = *(const float4*)(WSF(YBUF) + (size_t)t * 512 + 256 + lane * 4);
    const float4 z0 = *(const float4*)(WSF(PROJ) + (size_t)t * NIN + C_Z + lane * 4), z1 = *(const float4*)(WSF(PROJ) + (size_t)t * NIN + C_Z + 256 + lane * 4);
    const float4 sw = *(const float4*)(WSF(YCAT) + (size_t)t * 1024 + 768 + lane * 4);
    const int ms = WSI(MSEL)[(size_t)t * 4 + hh];
    const size_t base = ((size_t)t * 4 + hh) * 4;
    const bool ok0 = (ms & 63) != 63, ok1 = ((ms >> 6) & 63) != 63, ok2 = ((ms >> 12) & 63) != 63;
    float2 ml[4]; float4 pv[4];
    ml[0] = ok0 ? *(const float2*)(WSF(PARTML) + (base + 0) * 2) : make_float2(-INFINITY, 0.f);
    ml[1] = ok1 ? *(const float2*)(WSF(PARTML) + (base + 1) * 2) : make_float2(-INFINITY, 0.f);
    ml[2] = ok2 ? *(const float2*)(WSF(PARTML) + (base + 2) * 2) : make_float2(-INFINITY, 0.f);
    ml[3] = *(const float2*)(WSF(PARTML) + (base + 3) * 2);
    pv[0] = ok0 ? *(const float4*)(WSF(PARTO) + (base + 0) * 64 + d4) : make_float4(0.f, 0.f, 0.f, 0.f);
    pv[1] = ok1 ? *(const float4*)(WSF(PARTO) + (base + 1) * 64 + d4) : make_float4(0.f, 0.f, 0.f, 0.f);
    pv[2] = ok2 ? *(const float4*)(WSF(PARTO) + (base + 2) * 64 + d4) : make_float4(0.f, 0.f, 0.f, 0.f);
    pv[3] = *(const float4*)(WSF(PARTO) + (base + 3) * 64 + d4);
    float4 v0, v1;
    v0.x = y0.x * siluf(z0.x); v0.y = y0.y * siluf(z0.y); v0.z = y0.z * siluf(z0.z); v0.w = y0.w * siluf(z0.w);
    v1.x = y1.x * siluf(z1.x); v1.y = y1.y * siluf(z1.y); v1.z = y1.z * siluf(z1.z); v1.w = y1.w * siluf(z1.w);
    const float M = fmaxf(fmaxf(ml[0].x, ml[1].x), fmaxf(ml[2].x, ml[3].x));
    float4 o = make_float4(0.f, 0.f, 0.f, 0.f); float L = 0.f;
#pragma unroll
    for (int sl = 0; sl < 4; ++sl) {
      const float f = __builtin_amdgcn_exp2f(ml[sl].x - M);
      o.x += pv[sl].x * f; o.y += pv[sl].y * f; o.z += pv[sl].z * f; o.w += pv[sl].w * f; L += ml[sl].y * f;
    }
    const float il = 1.f / L;
    const float4 mo = make_float4(o.x * il, o.y * il, o.z * il, o.w * il);
    float s0 = v0.x * v0.x + v0.y * v0.y + v0.z * v0.z + v0.w * v0.w + v1.x * v1.x + v1.y * v1.y + v1.z * v1.z + v1.w * v1.w;
    float s1 = mo.x * mo.x + mo.y * mo.y + mo.z * mo.z + mo.w * mo.w;
    float s2 = sw.x * sw.x + sw.y * sw.y + sw.z * sw.z + sw.w * sw.w;
#pragma unroll
    for (int of = 32; of > 0; of >>= 1) { s0 += __shfl_xor(s0, of); s1 += __shfl_xor(s1, of); s2 += __shfl_xor(s2, of); }
    const float i0 = rsqrtf(s0 * (1.f / 512.f) + 1e-5f), i1 = rsqrtf(s1 * (1.f / 256.f) + 1e-5f), i2 = rsqrtf(s2 * (1.f / 256.f) + 1e-5f);
    bf16_t* yb = WSH(YCATB);
    *(uint2*)(yb + gt_off<16>(t, lane * 4)) = make_uint2(pack2bf(v0.x * i0 * gs0.x, v0.y * i0 * gs0.y), pack2bf(v0.z * i0 * gs0.z, v0.w * i0 * gs0.w));
    *(uint2*)(yb + gt_off<16>(t, lane * 4 + 256)) = make_uint2(pack2bf(v1.x * i0 * gs1.x, v1.y * i0 * gs1.y), pack2bf(v1.z * i0 * gs1.z, v1.w * i0 * gs1.w));
    *(uint2*)(yb + gt_off<16>(t, lane * 4 + 512)) = make_uint2(pack2bf(mo.x * i1 * gm.x, mo.y * i1 * gm.y), pack2bf(mo.z * i1 * gm.z, mo.w * i1 * gm.w));
    *(uint2*)(yb + gt_off<16>(t, lane * 4 + 768)) = make_uint2(pack2bf(sw.x * i2 * gw.x, sw.y * i2 * gw.y), pack2bf(sw.z * i2 * gw.z, sw.w * i2 * gw.w));
  }
}


__device__ __forceinline__ void phase_moba_gate(const Params& p) {
  const int gtid = blockIdx.x * NTHR + TIDX, gsz = gridDim.x * NTHR;
  for (int idx = gtid; idx < T * 4; idx += gsz) {
    const int hh = idx / T, t = idx % T, b = t / S, s = t & (S - 1), blk = s >> 8;
    float4 q[16];
    const float4* qp = (const float4*)(WSF(PROJ) + (size_t)t * NIN + C_MQ + hh * 64);
#pragma unroll
    for (int i = 0; i < 16; ++i) q[i] = qp[i];
    float v0 = -INFINITY, v1 = -INFINITY, v2 = -INFINITY; int i0 = 63, i1 = 63, i2 = 63;
#pragma unroll 2
    for (int n = 0; n < blk; ++n) {
      const float4* kp = (const float4*)(WSF(KMEAN) + ((b * 4 + hh) * 32 + n) * 64);
      float gsc = 0.f;
#pragma unroll
      for (int i = 0; i < 16; ++i) { const float4 k = kp[i]; gsc += q[i].x * k.x + q[i].y * k.y + q[i].z * k.z + q[i].w * k.w; }
      if (gsc > v0) { v2 = v1; i2 = i1; v1 = v0; i1 = i0; v0 = gsc; i0 = n; }
      else if (gsc > v1) { v2 = v1; i2 = i1; v1 = gsc; i1 = n; }
      else if (gsc > v2) { v2 = gsc; i2 = n; }
    }
    WSI(MSEL)[(size_t)t * 4 + hh] = i0 | (i1 << 6) | (i2 << 12);
  }
}

struct AttnSt { f32x16 o0, o1; float m, l; };
struct KFrag { bf16x8 a0, a1, a2, a3, b0, b1, b2, b3; };
__device__ __forceinline__ void attn_loadK(KFrag& f, const bf16_t* __restrict__ Kt, int ldk, int kt0, int lane) {
  (void)ldk;
  const bf16_t* kp = Kt + (size_t)(kt0 >> 6) * 4096 + lane * 8;
  f.a0 = *(const bf16x8*)(kp); f.a1 = *(const bf16x8*)(kp + 512); f.a2 = *(const bf16x8*)(kp + 1024); f.a3 = *(const bf16x8*)(kp + 1536);
  f.b0 = *(const bf16x8*)(kp + 2048); f.b1 = *(const bf16x8*)(kp + 2560); f.b2 = *(const bf16x8*)(kp + 3072); f.b3 = *(const bf16x8*)(kp + 3584);
}
__device__ __forceinline__ bf16x8 pk8(float a, float b, float c, float d, float e, float f, float g, float hh) {
  const unsigned w0 = pack2bf(a, b), w1 = pack2bf(c, d), w2 = pack2bf(e, f), w3 = pack2bf(g, hh);
  typedef unsigned u32x4 __attribute__((ext_vector_type(4)));
  const u32x4 u = {w0, w1, w2, w3};
  return __builtin_bit_cast(bf16x8, u);
}
template <int MODE>
__device__ __forceinline__ void attn_compute(KFrag& kf, const bf16_t* __restrict__ Kb, int ldk, int kt_next, const bf16_t* __restrict__ Vtb, int kt0, const bf16x8 (&qf)[4], int lo, int hi, float c, int lane, AttnSt& st) {
  const int h = lane >> 5, r31 = lane & 31;
  const bf16_t* vp = Vtb + (size_t)(kt0 >> 6) * 4096 + lane * 4;
  const bf16_t* vq = vp + 256;
  bf16x4 va[8], vb[8];
#pragma unroll
  for (int i = 0; i < 8; ++i) va[i] = *(const bf16x4*)(vp + i * 512);
  f32x16 s0, s1;
#pragma unroll
  for (int r = 0; r < 16; ++r) { s0[r] = 0.f; s1[r] = 0.f; }
  s0 = __builtin_amdgcn_mfma_f32_32x32x16_bf16(kf.a0, qf[0], s0, 0, 0, 0); s1 = __builtin_amdgcn_mfma_f32_32x32x16_bf16(kf.b0, qf[0], s1, 0, 0, 0);
  s0 = __builtin_amdgcn_mfma_f32_32x32x16_bf16(kf.a1, qf[1], s0, 0, 0, 0); s1 = __builtin_amdgcn_mfma_f32_32x32x16_bf16(kf.b1, qf[1], s1, 0, 0, 0);
  s0 = __builtin_amdgcn_mfma_f32_32x32x16_bf16(kf.a2, qf[2], s0, 0, 0, 0); s1 = __builtin_amdgcn_mfma_f32_32x32x16_bf16(kf.b2, qf[2], s1, 0, 0, 0);
  s0 = __builtin_amdgcn_mfma_f32_32x32x16_bf16(kf.a3, qf[3], s0, 0, 0, 0); s1 = __builtin_amdgcn_mfma_f32_32x32x16_bf16(kf.b3, qf[3], s1, 0, 0, 0);
  __builtin_amdgcn_sched_barrier(0);
  attn_loadK(kf, Kb, ldk, kt_next, lane);
#pragma unroll
  for (int i = 0; i < 8; ++i) vb[i] = *(const bf16x4*)(vq + i * 512);
  float tmax = -INFINITY;
  if (MODE == 1) {
    const int klo = lo - kt0 - 4 * h, khi = hi - kt0 - 4 * h;
#pragma unroll
    for (int r = 0; r < 16; ++r) {
      const int k0c = (r & 3) + 8 * (r >> 2);
      s0[r] = (k0c >= klo && k0c <= khi) ? s0[r] : -INFINITY;
      s1[r] = (k0c + 32 >= klo && k0c + 32 <= khi) ? s1[r] : -INFINITY;
    }
  }
#pragma unroll
  for (int r = 0; r < 16; ++r) tmax = fmaxf(tmax, fmaxf(s0[r], s1[r]));
  tmax = fmaxf(tmax, __shfl_xor(tmax, 32));
  const float mnew = fmaxf(st.m, tmax * c);
  const float msafe = (mnew == -INFINITY) ? 0.f : mnew;
  const float alpha = __builtin_amdgcn_exp2f(st.m - msafe);
  st.m = mnew;
  float psum = 0.f;
#pragma unroll
  for (int r = 0; r < 16; ++r) {
    s0[r] = __builtin_amdgcn_exp2f(fmaf(s0[r], c, -msafe));
    s1[r] = __builtin_amdgcn_exp2f(fmaf(s1[r], c, -msafe));
    psum += s0[r] + s1[r];
  }
  st.l = st.l * alpha + psum;
  if (__any(alpha != 1.f)) {
#pragma unroll
    for (int r = 0; r < 16; ++r) { st.o0[r] *= alpha; st.o1[r] *= alpha; }
  }
  const bf16x8 p0 = pk8(s0[0], s0[1], s0[2], s0[3], s0[4], s0[5], s0[6], s0[7]);
  const bf16x8 p1 = pk8(s0[8], s0[9], s0[10], s0[11], s0[12], s0[13], s0[14], s0[15]);
  const bf16x8 p2 = pk8(s1[0], s1[1], s1[2], s1[3], s1[4], s1[5], s1[6], s1[7]);
  const bf16x8 p3 = pk8(s1[8], s1[9], s1[10], s1[11], s1[12], s1[13], s1[14], s1[15]);
#define VF(x, i) ((bf16x8){x[2 * i][0], x[2 * i][1], x[2 * i][2], x[2 * i][3], x[2 * i + 1][0], x[2 * i + 1][1], x[2 * i + 1][2], x[2 * i + 1][3]})
  st.o0 = __builtin_amdgcn_mfma_f32_32x32x16_bf16(VF(va, 0), p0, st.o0, 0, 0, 0); st.o1 = __builtin_amdgcn_mfma_f32_32x32x16_bf16(VF(vb, 0), p0, st.o1, 0, 0, 0);
  st.o0 = __builtin_amdgcn_mfma_f32_32x32x16_bf16(VF(va, 1), p1, st.o0, 0, 0, 0); st.o1 = __builtin_amdgcn_mfma_f32_32x32x16_bf16(VF(vb, 1), p1, st.o1, 0, 0, 0);
  st.o0 = __builtin_amdgcn_mfma_f32_32x32x16_bf16(VF(va, 2), p2, st.o0, 0, 0, 0); st.o1 = __builtin_amdgcn_mfma_f32_32x32x16_bf16(VF(vb, 2), p2, st.o1, 0, 0, 0);
  st.o0 = __builtin_amdgcn_mfma_f32_32x32x16_bf16(VF(va, 3), p3, st.o0, 0, 0, 0); st.o1 = __builtin_amdgcn_mfma_f32_32x32x16_bf16(VF(vb, 3), p3, st.o1, 0, 0, 0);
#undef VF
}
template <int MODE>
__device__ __forceinline__ void attn_run(const bf16_t* __restrict__ Kb, int ldk, const bf16_t* __restrict__ Vtb, int kt_first, int ntiles, const bf16x8 (&qf)[4], int lo, int hi, float c, int lane, AttnSt& st) {
  KFrag kf;
  attn_loadK(kf, Kb, ldk, kt_first, lane);
#pragma unroll 1
  for (int i = 0; i < ntiles; ++i) {
    const int ktn = (i + 1 < ntiles) ? kt_first + 64 * (i + 1) : kt_first;
    attn_compute<MODE>(kf, Kb, ldk, ktn, Vtb, kt_first + 64 * i, qf, lo, hi, c, lane, st);
  }
}
__device__ __forceinline__ void attn_init(AttnSt& st) {
#pragma unroll
  for (int r = 0; r < 16; ++r) { st.o0[r] = 0.f; st.o1[r] = 0.f; }
  st.m = -INFINITY; st.l = 0.f;
}
__device__ __forceinline__ void attn_store(const AttnSt& st, float scale, float* outp, int h) {
#pragma unroll
  for (int g = 0; g < 4; ++g) {
    *(float4*)(outp + g * 8 + 4 * h) = make_float4(st.o0[g * 4 + 0] * scale, st.o0[g * 4 + 1] * scale, st.o0[g * 4 + 2] * scale, st.o0[g * 4 + 3] * scale);
    *(float4*)(outp + 32 + g * 8 + 4 * h) = make_float4(st.o1[g * 4 + 0] * scale, st.o1[g * 4 + 1] * scale, st.o1[g * 4 + 2] * scale, st.o1[g * 4 + 3] * scale);
  }
}
__device__ __forceinline__ void phase_attn2(const Params& p, int l, char* smem) {
  const int tid = TIDX, lane = tid & 63, w = tid >> 6, h = lane >> 5, ql = lane & 31;
  const float c = 0.125f * 1.4426950408889634f;
  volatile unsigned short* qlist = (volatile unsigned short*)(smem + 65536) + w * 128;
  const int gw = blockIdx.x * (NTHR / 64) + w, nw = gridDim.x * (NTHR / 64);
  constexpr int NPAST = 2 * 8 * 496, NOWN = 2048, NSWA = 2048;
  for (int itb = 0;; ++itb) {
    const int nb_ = (int)gridDim.x, brank = itb * nb_ + ((itb & 1) ? (nb_ - 1 - (int)blockIdx.x) : (int)blockIdx.x);
    if (brank >= 8 * 271) break;
    {
      const int bh = brank & 7, r_ = brank >> 3, b = bh >> 2, hh = bh & 3;
      int pp = (int)((-1.f + sqrtf(1.f + 4.f * (float)r_)) * 0.5f);
      while (pp * (pp + 1) > r_) --pp;
      while ((pp + 1) * (pp + 2) <= r_) ++pp;
      const int j = r_ - pp * (pp + 1), qb = 2 * pp + 1 + (w >> 1), qh = w & 1;
      __syncthreads();
      {
        const uint4* gk = (const uint4*)(WSH(MKT) + ((size_t)bh * 128 + j * 4) * 4096);
        const uint4* gv = (const uint4*)(WSH(MVT) + ((size_t)bh * 128 + j * 4) * 4096);
        uint4 tk[8], tv[8];
#pragma unroll
        for (int i = 0; i < 8; ++i) { tk[i] = gk[tid + i * NTHR]; tv[i] = gv[tid + i * NTHR]; }
#pragma unroll
        for (int i = 0; i < 8; ++i) { ((uint4*)smem)[tid + i * NTHR] = tk[i]; ((uint4*)(smem + 32768))[tid + i * NTHR] = tv[i]; }
      }
      __syncthreads();
      if (qb > 31 || j >= qb) continue;
      int n = 0;
#pragma unroll
      for (int g = 2 * qh; g < 2 * qh + 2; ++g) {
        const int ms = WSI(MSEL)[((size_t)b * S + qb * 256 + g * 64 + lane) * 4 + hh];
        const int slot = ((ms & 63) == j) ? 0 : ((((ms >> 6) & 63) == j) ? 1 : ((((ms >> 12) & 63) == j) ? 2 : -1));
        const unsigned long long mask = __ballot(slot >= 0);
        const int pos = n + __popcll(mask & ((1ull << lane) - 1ull));
        if (slot >= 0) qlist[pos] = (unsigned short)((g * 64 + lane) | (slot << 8));
        n += __popcll(mask);
      }
      if (n == 0) continue;
      const bf16_t* Kb = (const bf16_t*)smem;
      const bf16_t* Vtb = (const bf16_t*)(smem + 32768);
      for (int qt = 0; qt * 32 < n; ++qt) {
        const int idx = qt * 32 + ql;
        const bool valid = idx < n;
        const unsigned ent = qlist[valid ? idx : 0];
        const size_t t = (size_t)b * S + qb * 256 + (ent & 255u);
        bf16x8 qf[4];
#pragma unroll
        for (int ks = 0; ks < 4; ++ks) qf[ks] = *(const bf16x8*)(WSH(MQK) + t * 512 + hh * 64 + 16 * ks + 8 * h);
        AttnSt st; attn_init(st);
        attn_run<0>(Kb, 512, Vtb, 0, 4, qf, 0, 0, c, lane, st);
        const float lt = st.l + __shfl_xor(st.l, 32);
        if (valid) {
          const size_t base = (t * 4 + hh) * 4 + (ent >> 8);
          attn_store(st, 1.f, WSF(PARTO) + base * 64, h);
          if (h == 0) *(float2*)(WSF(PARTML) + base * 2) = make_float2(st.m, lt);
        }
      }
    }
  }
  for (int it = 0;; ++it) {
    const int rank = NPAST + it * nw + ((it & 1) ? (nw - 1 - gw) : gw);
    if (rank >= NPAST + NOWN + NSWA) break;
    if (rank < NPAST + NOWN) {
      const int r2 = rank - NPAST, sub = 7 - (r2 >> 8), bh = r2 & 7, blk = (r2 >> 3) & 31, b = bh >> 2, hh = bh & 3;
      const int q0 = blk * 256 + sub * 32, n_own = (sub * 32 + 31) / 64 + 1;
      const size_t t = (size_t)b * S + q0 + ql;
      bf16x8 qf[4];
#pragma unroll
      for (int ks = 0; ks < 4; ++ks) qf[ks] = *(const bf16x8*)(WSH(MQK) + t * 512 + hh * 64 + 16 * ks + 8 * h);
      AttnSt st; attn_init(st);
      attn_run<1>(WSH(MKT) + (size_t)(b * 4 + hh) * 64 * S, 512, WSH(MVT) + (size_t)(b * 4 + hh) * 64 * S, blk * 256, n_own, qf, 0, q0 + ql, c, lane, st);
      const float lt = st.l + __shfl_xor(st.l, 32);
      const size_t base = (t * 4 + hh) * 4 + 3;
      attn_store(st, 1.f, WSF(PARTO) + base * 64, h);
      if (h == 0) *(float2*)(WSF(PARTML) + base * 2) = make_float2(st.m, lt);
    } else {
      const int r3 = rank - NPAST - NOWN, qt = r3 & 255, hq = (r3 >> 8) & 3, kvh = hq >> 1, b = r3 >> 10, q0 = qt * 32;
      const size_t t = (size_t)b * S + q0 + ql;
      bf16x8 qf[4];
#pragma unroll
      for (int ks = 0; ks < 4; ++ks) qf[ks] = *(const bf16x8*)(WSH(SQK) + t * 384 + hq * 64 + 16 * ks + 8 * h);
      const int first = (q0 >= 127 ? q0 - 127 : 0) >> 6, last = (q0 + 31) >> 6;
      AttnSt st; attn_init(st);
      attn_run<1>(WSH(SKT) + (size_t)(b * 2 + kvh) * 64 * S, 384, WSH(SVT) + (size_t)(b * 2 + kvh) * 64 * S, first * 64, last - first + 1, qf, q0 + ql - 127, q0 + ql, c, lane, st);
      const float lt = st.l + __shfl_xor(st.l, 32);
      const float sinkv = p.swa_sinks[l * 4 + hq] * 1.4426950408889634f;
      const float M = fmaxf(st.m, sinkv), f = __builtin_amdgcn_exp2f(st.m - M);
      const float L = lt * f + __builtin_amdgcn_exp2f(sinkv - M);
      attn_store(st, f / L, WSF(YCAT) + t * 1024 + 768 + hq * 64, h);
    }
  }
}


__device__ __forceinline__ unsigned fkey(float v) { const unsigned u = __float_as_uint(v); return (u & 0x80000000u) ? ~u : (u | 0x80000000u); }
template <unsigned MASK> __device__ __forceinline__ float kval(unsigned k) {
  const unsigned u = (k & 0x80000000u) ? (k & 0x7fffffffu) : ~k;
  return __uint_as_float(u & ~MASK);
}
__device__ __forceinline__ void ins16(unsigned (&L)[16], unsigned x) {
#pragma unroll
  for (int j = 0; j < 16; ++j) { const unsigned hi = max(L[j], x); x = min(L[j], x); L[j] = hi; }
}
__device__ __forceinline__ void ce_desc(unsigned& hi, unsigned& lo) { const unsigned a = max(hi, lo), b = min(hi, lo); hi = a; lo = b; }
__device__ __forceinline__ void sort16_desc(unsigned (&v)[16]) {
#pragma unroll
  for (int k = 2; k <= 16; k <<= 1)
#pragma unroll
    for (int j = k >> 1; j > 0; j >>= 1)
#pragma unroll
      for (int i = 0; i < 16; ++i) {
        const int l = i ^ j;
        if (l > i) { if ((i & k) == 0) ce_desc(v[i], v[l]); else ce_desc(v[l], v[i]); }
      }
}
__device__ __forceinline__ void top16_merge(unsigned (&a)[16], const unsigned (&b)[16]) {
#pragma unroll
  for (int i = 0; i < 16; ++i) a[i] = max(a[i], b[15 - i]);
#pragma unroll
  for (int j = 8; j > 0; j >>= 1)
#pragma unroll
    for (int i = 0; i < 16; ++i) { const int l = i ^ j; if (l > i) ce_desc(a[i], a[l]); }
}
__device__ __forceinline__ unsigned csel(unsigned cond, unsigned a, unsigned b) {
  unsigned r;
  asm("v_cmp_ne_u32 vcc, 0, %1\n\tv_cndmask_b32 %0, %2, %3, vcc" : "=v"(r) : "v"(cond), "v"(a), "v"(b) : "vcc");
  return r;
}
__device__ __forceinline__ unsigned sel16(const unsigned (&A)[16], unsigned a) {
  const unsigned b0 = a & 1u, b1 = a & 2u, b2 = a & 4u, b3 = a & 8u;
  const unsigned t0 = csel(b0, A[0], A[1]), t1 = csel(b0, A[2], A[3]), t2 = csel(b0, A[4], A[5]), t3 = csel(b0, A[6], A[7]);
  const unsigned t4 = csel(b0, A[8], A[9]), t5 = csel(b0, A[10], A[11]), t6 = csel(b0, A[12], A[13]), t7 = csel(b0, A[14], A[15]);
  const unsigned u0 = csel(b1, t0, t1), u1 = csel(b1, t2, t3), u2 = csel(b1, t4, t5), u3 = csel(b1, t6, t7);
  const unsigned w0 = csel(b2, u0, u1), w1 = csel(b2, u2, u3);
  return csel(b3, w0, w1);
}
__device__ __forceinline__ unsigned sel16_packed(unsigned w0, unsigned w1, unsigned w2, unsigned w3, unsigned a) {
  const unsigned lo = csel(a & 4u, w0, w1), hi = csel(a & 4u, w2, w3), w = csel(a & 8u, lo, hi);
  return (w >> ((a & 3u) * 8u)) & 0xffu;
}
__device__ __forceinline__ void peer_half_top16(const char* kmat, const bf16_t* qcol, const int (&aoff)[8], int h4, unsigned (&L)[16]) {
  bf16x8 bq[8];
#pragma unroll
  for (int s = 0; s < 8; ++s) bq[s] = *(const bf16x8*)(qcol + s * 8);
#pragma unroll
  for (int j = 0; j < 16; ++j) L[j] = 0u;
#pragma unroll
  for (int nt = 0; nt < 4; ++nt) {
    f32x16 acc;
#pragma unroll
    for (int r = 0; r < 16; ++r) acc[r] = 0.f;
#pragma unroll
    for (int s = 0; s < 8; ++s) {
      const bf16x8 ak = *(const bf16x8*)(kmat + nt * 8192 + aoff[s]);
      acc = __builtin_amdgcn_mfma_f32_32x32x16_bf16(ak, bq[s], acc, 0, 0, 0);
    }
    unsigned kt[16];
#pragma unroll
    for (int r = 0; r < 16; ++r) {
      const int nconst = nt * 32 + (r & 3) + 8 * (r >> 2);
      kt[r] = (fkey(acc[r]) & ~127u) | (unsigned)(127 - nconst - h4);
    }
    sort16_desc(kt);
    if (nt == 0) {
#pragma unroll
      for (int j = 0; j < 16; ++j) L[j] = kt[j];
    } else top16_merge(L, kt);
    __builtin_amdgcn_sched_barrier(0);
  }
  unsigned P[16];
#pragma unroll
  for (int j = 0; j < 16; ++j) P[j] = __shfl_xor(L[j], 32);
  top16_merge(L, P);
}
__device__ __forceinline__ void phase_peer_topk2(const Params& p, int l, char* smem) {
  const int tid = TIDX, lane = tid & 63;
  {
    const uint4* ksrc = (const uint4*)(WSH(K12B) + (size_t)l * 32768);
    for (int i = tid; i < 4096; i += NTHR) {
      const int mat = i >> 11, r = (i >> 4) & 127, c = i & 15;
      *(uint4*)(smem + mat * 32768 + r * 256 + ((c ^ (r & 15)) << 4)) = ksrc[i];
    }
  }
  __syncthreads();
  const int h = lane >> 5, cl = lane & 31;
  int aoff[8];
#pragma unroll
  for (int s = 0; s < 8; ++s) aoff[s] = cl * 256 + ((((h * 8) ^ (lane & 15)) ^ s) << 4);
  const int gw = (blockIdx.x * NTHR + tid) >> 6, nw = gridDim.x * (NTHR / 64);
  for (int unit = gw; unit < T * 8 / 32; unit += nw) {
    const size_t col = (size_t)unit * 32 + cl;
    const bf16_t* qcol = WSH(QB) + col * 256 + h * 64;
    unsigned L1[16], L2[16];
    peer_half_top16(smem, qcol, aoff, 4 * h, L1);
    peer_half_top16(smem + 32768, qcol + 128, aoff, 4 * h, L2);
    float v1[16], v2[16];
#pragma unroll
    for (int j = 0; j < 16; ++j) { v1[j] = kval<127u>(L1[j]); v2[j] = kval<127u>(L2[j]); }
#define CKEY(a, b) ((fkey(v1[a] + v2[b]) & ~255u) | (unsigned)(255 - ((a) * 16 + (b))))
    unsigned C[16];
#pragma unroll
    for (int b = 0; b < 16; ++b) C[b] = CKEY(0, b);
    __builtin_amdgcn_sched_barrier(0);
#pragma unroll
    for (int a = 1; a <= 4; ++a) {
      unsigned R[16];
#pragma unroll
      for (int b = 0; b < 16; ++b) R[b] = (b < 16 / (a + 1)) ? CKEY(a, b) : 0u;
      top16_merge(C, R);
      __builtin_amdgcn_sched_barrier(0);
    }
#pragma unroll
    for (int a = 5; a < 16; ++a) {
#pragma unroll
      for (int b = 0; b < 16 / (a + 1); ++b) ins16(C, CKEY(a, b));
      if (a & 1) __builtin_amdgcn_sched_barrier(0);
    }
#undef CKEY
    unsigned P1[4], P2[4];
#pragma unroll
    for (int k = 0; k < 4; ++k) {
      P1[k] = (L1[4 * k] & 127u) | ((L1[4 * k + 1] & 127u) << 8) | ((L1[4 * k + 2] & 127u) << 16) | ((L1[4 * k + 3] & 127u) << 24);
      P2[k] = (L2[4 * k] & 127u) | ((L2[4 * k + 1] & 127u) << 8) | ((L2[4 * k + 2] & 127u) << 16) | ((L2[4 * k + 3] & 127u) << 24);
    }
    float ex[16]; unsigned ee[16]; float sum = 0.f;
    const float mx = kval<255u>(C[0]);
#pragma unroll
    for (int k = 0; k < 16; ++k) {
      const unsigned ci = 255u - (C[k] & 255u);
      ee[k] = (127u - sel16_packed(P1[0], P1[1], P1[2], P1[3], ci >> 4)) * 128u + (127u - sel16_packed(P2[0], P2[1], P2[2], P2[3], ci & 15u));
      ex[k] = __expf(kval<255u>(C[k]) - mx);
      sum += ex[k];
    }
    const float inv = 1.f / sum;
    unsigned* dst = h ? (unsigned*)(WSF(GVAL) + col * 16) : (unsigned*)(WSI(EIDX) + col * 16);
#pragma unroll
    for (int k4 = 0; k4 < 4; ++k4) {
      uint4 w;
      w.x = h ? __float_as_uint(ex[4 * k4 + 0] * inv) : ee[4 * k4 + 0];
      w.y = h ? __float_as_uint(ex[4 * k4 + 1] * inv) : ee[4 * k4 + 1];
      w.z = h ? __float_as_uint(ex[4 * k4 + 2] * inv) : ee[4 * k4 + 2];
      w.w = h ? __float_as_uint(ex[4 * k4 + 3] * inv) : ee[4 * k4 + 3];
      *(uint4*)(dst + 4 * k4) = w;
    }
  }
  __syncthreads();
}


typedef float f32x2 __attribute__((ext_vector_type(2)));
__device__ __forceinline__ float dot16_fp8(const uint4 w, const float (&h)[16]) {
  float s = 0.f;
  const unsigned ww[4] = {w.x, w.y, w.z, w.w};
#pragma unroll
  for (int i = 0; i < 4; ++i) {
    const f32x2 lo = __builtin_amdgcn_cvt_pk_f32_fp8((int)ww[i], false), hi = __builtin_amdgcn_cvt_pk_f32_fp8((int)ww[i], true);
    s += lo[0] * h[4 * i] + lo[1] * h[4 * i + 1] + hi[0] * h[4 * i + 2] + hi[1] * h[4 * i + 3];
  }
  return s;
}
__device__ __forceinline__ void axpy16_fp8(float a, const uint4 w, float (&acc)[16]) {
  const unsigned ww[4] = {w.x, w.y, w.z, w.w};
#pragma unroll
  for (int i = 0; i < 4; ++i) {
    const f32x2 lo = __builtin_amdgcn_cvt_pk_f32_fp8((int)ww[i], false), hi = __builtin_amdgcn_cvt_pk_f32_fp8((int)ww[i], true);
    acc[4 * i] += a * lo[0]; acc[4 * i + 1] += a * lo[1]; acc[4 * i + 2] += a * hi[0]; acc[4 * i + 3] += a * hi[1];
  }
}

struct PeerDist { int first, count, slice0, nslice; };
__device__ __forceinline__ PeerDist peer_dist(unsigned xcc, unsigned nloc, unsigned nx, unsigned rank, int w) {
  PeerDist d;
  if (nx == 8u && xcc < 8u) { d.first = (int)rank * (NTHR / 64) + w; d.count = (int)nloc * (NTHR / 64); d.slice0 = (int)xcc; d.nslice = 1; }
  else { d.first = (int)blockIdx.x * (NTHR / 64) + w; d.count = (int)gridDim.x * (NTHR / 64); d.slice0 = 0; d.nslice = 8; }
  return d;
}
__device__ __forceinline__ void peer_gather8(uint4 (&r)[8], const unsigned char* __restrict__ tab, int eh, int colbyte, int g) {
#pragma unroll
  for (int j = 0; j < 8; ++j) {
    const int e = __shfl(eh, j * 8 + g);
    r[j] = *(const uint4*)(tab + (size_t)e * 128 + colbyte);
  }
}
__device__ __forceinline__ void phase_peer_u(const Params& p, int l, const PeerDist dist) {
  const int lane = TIDX & 63, g = lane >> 3, sub = lane & 7;
  for (int sl = dist.slice0; sl < dist.slice0 + dist.nslice; ++sl) {
    const unsigned char* U = (const unsigned char*)(p.ws + OFF_UB) + ((size_t)(l * 8 + sl)) * 16384 * 128 + sub * 16;
    const int colb = sl * 128 + sub * 16, step = dist.count;
    const int n = (dist.first < T) ? (T - 1 - dist.first) / step + 1 : 0;
    if (n == 0) continue;
    uint4 rA[8], rB[8];
    int e0 = WSI(EIDX)[(size_t)dist.first * 128 + lane], e1 = WSI(EIDX)[(size_t)dist.first * 128 + 64 + lane];
    peer_gather8(rA, U, e0, 0, g);
#pragma unroll 1
    for (int i = 0; i < n; ++i) {
      const int t = dist.first + i * step, tn = dist.first + (i + 1 < n ? i + 1 : i) * step;
      peer_gather8(rB, U, e1, 0, g);
      const int ne0 = WSI(EIDX)[(size_t)tn * 128 + lane], ne1 = WSI(EIDX)[(size_t)tn * 128 + 64 + lane];
      float h[16];
      {
        const uint4 ha = *(const uint4*)(WSH(HB) + gt_off<16>(t, colb)), hb = *(const uint4*)(WSH(HB) + gt_off<16>(t, colb + 8));
        h[0] = bflo(ha.x); h[1] = bfhi(ha.x); h[2] = bflo(ha.y); h[3] = bfhi(ha.y); h[4] = bflo(ha.z); h[5] = bfhi(ha.z); h[6] = bflo(ha.w); h[7] = bfhi(ha.w);
        h[8] = bflo(hb.x); h[9] = bfhi(hb.x); h[10] = bflo(hb.y); h[11] = bfhi(hb.y); h[12] = bflo(hb.z); h[13] = bfhi(hb.z); h[14] = bflo(hb.w); h[15] = bfhi(hb.w);
      }
      __builtin_amdgcn_sched_barrier(0);
      float d0[8], d1[8];
#pragma unroll
      for (int j = 0; j < 8; ++j) d0[j] = dot16_fp8(rA[j], h);
      __builtin_amdgcn_sched_barrier(0);
      peer_gather8(rA, U, ne0, 0, g);
      __builtin_amdgcn_sched_barrier(0);
#pragma unroll
      for (int j = 0; j < 8; ++j) d1[j] = dot16_fp8(rB[j], h);
#pragma unroll
      for (int o = 1; o < 8; o <<= 1) {
#pragma unroll
        for (int j = 0; j < 8; ++j) { d0[j] += __shfl_xor(d0[j], o); d1[j] += __shfl_xor(d1[j], o); }
      }
      float v0 = d0[0], v1 = d1[0];
#pragma unroll
      for (int j = 1; j < 8; ++j) { v0 = (sub == j) ? d0[j] : v0; v1 = (sub == j) ? d1[j] : v1; }
      float* pp = WSF(PP) + ((size_t)sl * T + t) * 128;
      pp[sub * 8 + g] = v0; pp[64 + sub * 8 + g] = v1;
      e0 = ne0; e1 = ne1;
      __builtin_amdgcn_sched_barrier(0);
    }
  }
}
__device__ __forceinline__ void phase_peer_r(const Params& p, int l) {
  const int gtid = blockIdx.x * NTHR + TIDX, gsz = gridDim.x * NTHR;
  const float* SU = WSF(SUV) + (size_t)(l * 2) * 16384; const float* SV = SU + 16384;
  for (int i4 = gtid; i4 < T * 128 / 4; i4 += gsz) {
    float4 s = make_float4(0.f, 0.f, 0.f, 0.f);
#pragma unroll
    for (int x = 0; x < 8; ++x) { const float4 v = ((const float4*)(WSF(PP) + (size_t)x * T * 128))[i4]; s.x += v.x; s.y += v.y; s.z += v.z; s.w += v.w; }
    const int4 e = ((const int4*)WSI(EIDX))[i4];
    const float4 gv = ((const float4*)WSF(GVAL))[i4];
    const float p0 = s.x * SU[e.x], p1 = s.y * SU[e.y], p2 = s.z * SU[e.z], p3 = s.w * SU[e.w];
    float4 o;
    o.x = 0.5f * p0 * (1.f + erff(p0 * 0.70710678118654752f)) * gv.x * SV[e.x];
    o.y = 0.5f * p1 * (1.f + erff(p1 * 0.70710678118654752f)) * gv.y * SV[e.y];
    o.z = 0.5f * p2 * (1.f + erff(p2 * 0.70710678118654752f)) * gv.z * SV[e.z];
    o.w = 0.5f * p3 * (1.f + erff(p3 * 0.70710678118654752f)) * gv.w * SV[e.w];
    ((float4*)WSF(ACT))[i4] = o;
  }
}
__device__ __forceinline__ void phase_peer_v(const Params& p, int l, const PeerDist dist) {
  const int lane = TIDX & 63, g = lane >> 3, sub = lane & 7;
  const float* g2 = WSF(MOD) + (size_t)l * 2 * 6 * D + 5 * D;
  for (int sl = dist.slice0; sl < dist.slice0 + dist.nslice; ++sl) {
    const unsigned char* V = (const unsigned char*)(p.ws + OFF_VB) + ((size_t)(l * 8 + sl)) * 16384 * 128 + sub * 16;
    const int step = dist.count;
    const int n = (dist.first < T) ? (T - 1 - dist.first) / step + 1 : 0;
    if (n == 0) continue;
    uint4 rA[8], rB[8];
    int e0 = WSI(EIDX)[(size_t)dist.first * 128 + lane], e1 = WSI(EIDX)[(size_t)dist.first * 128 + 64 + lane];
    peer_gather8(rA, V, e0, 0, g);
#pragma unroll 1
    for (int i = 0; i < n; ++i) {
      const int t = dist.first + i * step, tn = dist.first + (i + 1 < n ? i + 1 : i) * step;
      peer_gather8(rB, V, e1, 0, g);
      const int ne0 = WSI(EIDX)[(size_t)tn * 128 + lane], ne1 = WSI(EIDX)[(size_t)tn * 128 + 64 + lane];
      const float a0 = WSF(ACT)[(size_t)t * 128 + lane], a1 = WSF(ACT)[(size_t)t * 128 + 64 + lane];
      const int col = sl * 128 + sub * 16 + 2 * g;
      const float2 gt = *(const float2*)(g2 + (t / S) * 6 * D + col);
      float2* xp = (float2*)(WSF(XCUR) + (size_t)t * D + col);
      float2 xv = *xp;
      __builtin_amdgcn_sched_barrier(0);
      float acc[16];
#pragma unroll
      for (int j = 0; j < 16; ++j) acc[j] = 0.f;
#pragma unroll
      for (int j = 0; j < 8; ++j) axpy16_fp8(__shfl(a0, j * 8 + g), rA[j], acc);
      __builtin_amdgcn_sched_barrier(0);
      peer_gather8(rA, V, ne0, 0, g);
      __builtin_amdgcn_sched_barrier(0);
#pragma unroll
      for (int j = 0; j < 8; ++j) axpy16_fp8(__shfl(a1, j * 8 + g), rB[j], acc);
#pragma unroll
      for (int o = 8; o < 64; o <<= 1) {
#pragma unroll
        for (int j = 0; j < 16; ++j) acc[j] += __shfl_xor(acc[j], o);
      }
      float w0 = acc[0], w1 = acc[1];
#pragma unroll
      for (int j = 1; j < 8; ++j) { w0 = (g == j) ? acc[2 * j] : w0; w1 = (g == j) ? acc[2 * j + 1] : w1; }
      xv.x += gt.x * w0; xv.y += gt.y * w1; *xp = xv;
      e0 = ne0; e1 = ne1;
      __builtin_amdgcn_sched_barrier(0);
    }
  }
}

__device__ __forceinline__ void phase_final(const Params& p) {
  const int wave = (blockIdx.x * NTHR + TIDX) >> 6, nw = gridDim.x * (NTHR / 64), lane = TIDX & 63;
  for (int t = wave; t < T; t += nw) {
    const float4* xr = (const float4*)(WSF(XCUR) + (size_t)t * D);
    float4 v[4]; float ss = 0.f;
#pragma unroll
    for (int i = 0; i < 4; ++i) { v[i] = xr[lane + 64 * i]; ss += v[i].x * v[i].x + v[i].y * v[i].y + v[i].z * v[i].z + v[i].w * v[i].w; }
    ss = wave_sum(ss);
    const float inv = rsqrtf(ss * (1.f / D) + 1e-5f);
    float4* orow = (float4*)(p.out + (size_t)t * D);
#pragma unroll
    for (int i = 0; i < 4; ++i) {
      const float4 g4 = *(const float4*)(p.final_g + (lane + 64 * i) * 4);
      orow[lane + 64 * i] = make_float4(v[i].x * inv * g4.x, v[i].y * inv * g4.y, v[i].z * inv * g4.z, v[i].w * inv * g4.w);
    }
  }
}

#define XB_TMO      128
#define XB_XCNT(j)  (256  + 64 * (j))
#define XB_XSUB(j)  (1280 + 64 * (j))
#define XB_XGEN(j)  (2304 + 64 * (j))
#define XB_TOP      3328
#define XB_TOPGEN   3392
#define XCD_BAR_WORDS 3456
#define XB_SPIN_CAP (1u << 18)
__device__ __forceinline__ unsigned xb_ld(unsigned* p)              { return __hip_atomic_load(p, __ATOMIC_RELAXED, __HIP_MEMORY_SCOPE_AGENT); }
__device__ __forceinline__ unsigned xb_add(unsigned* p, unsigned v) { return __hip_atomic_fetch_add(p, v, __ATOMIC_RELAXED, __HIP_MEMORY_SCOPE_AGENT); }
__device__ __forceinline__ unsigned xb_xcc_id() { return (unsigned)__builtin_amdgcn_s_getreg((3 << 11) | 20) & 0xFu; }
#define XB_SPIN(cond, bar) do { unsigned _sp = 0; while (cond) { __builtin_amdgcn_s_sleep(1); \
    if ((++_sp & 255u) == 0u) { if (xb_ld(&(bar)[XB_TMO])) break; if (_sp > XB_SPIN_CAP) { atomicAdd(&(bar)[XB_TMO], 1u); break; } } } } while (0)
struct XcdBarrier { volatile LAS unsigned* st; };
__device__ __forceinline__ XcdBarrier xcd_barrier_post(unsigned* bar, volatile LAS unsigned* st) {
  XcdBarrier b; b.st = st;
  if (threadIdx.x == 0) st[2] = xb_add(&bar[XB_XCNT(xb_xcc_id())], 1u);
  return b;
}
__device__ __forceinline__ void xcd_barrier_complete(unsigned* bar, unsigned x, unsigned& nloc, unsigned& nx) {
  const unsigned G = gridDim.x * gridDim.y * gridDim.z;
  unsigned sum, cnt, mine, sp = 0u;
  for (;;) {
    sum = 0u; cnt = 0u; mine = 0u;
#pragma unroll
    for (unsigned j = 0; j < 16; ++j) { const unsigned c = xb_ld(&bar[XB_XCNT(j)]); sum += c; cnt += (c > 0u) ? 1u : 0u; mine = (j == x) ? c : mine; }
    if (sum == G) break;
    __builtin_amdgcn_s_sleep(1);
    if ((++sp & 255u) == 0u) { if (xb_ld(&bar[XB_TMO])) break; if (sp > XB_SPIN_CAP) { atomicAdd(&bar[XB_TMO], 1u); break; } }
  }
  nloc = mine > 0u ? mine : 1u; nx = cnt > 0u ? cnt : 1u;
}
__device__ __forceinline__ void xcd_barrier(const XcdBarrier& b, char* ws) {
  asm volatile("s_waitcnt vmcnt(0)" ::: "memory");
  __syncthreads();
  if (threadIdx.x == 0) {
    unsigned wlo = __builtin_amdgcn_readfirstlane((unsigned)((unsigned long long)ws & 0xffffffffull));
    unsigned whi = __builtin_amdgcn_readfirstlane((unsigned)((unsigned long long)ws >> 32));
    asm volatile("" : "+s"(wlo), "+s"(whi));
    unsigned* bar = (unsigned*)((char*)(((unsigned long long)whi << 32) | wlo) + OFF_BAR);
    const unsigned x = xb_xcc_id();
    __builtin_amdgcn_s_waitcnt(0);
    unsigned nloc = b.st[0], nx = b.st[1];
    if (nloc == 0u) { xcd_barrier_complete(bar, x, nloc, nx); b.st[0] = nloc; b.st[1] = nx; }
    const unsigned old = xb_add(&bar[XB_XSUB(x)], 1u);
    const unsigned gen = old / nloc;
    if (old + 1u == (gen + 1u) * nloc) {
      __builtin_amdgcn_fence(__ATOMIC_RELEASE, "agent");
      asm volatile("s_waitcnt vmcnt(0)" ::: "memory");
      const unsigned og = xb_add(&bar[XB_TOP], 1u);
      const unsigned tg = og / nx;
      if (og + 1u == (tg + 1u) * nx) xb_add(&bar[XB_TOPGEN], 1u);
      else XB_SPIN(xb_ld(&bar[XB_TOPGEN]) == tg, bar);
      __builtin_amdgcn_fence(__ATOMIC_ACQUIRE, "agent");
      xb_add(&bar[XB_XGEN(x)], 1u);
      asm volatile("s_waitcnt vmcnt(0)" ::: "memory");
    } else {
      XB_SPIN(xb_ld(&bar[XB_XGEN(x)]) == gen, bar);
      __builtin_amdgcn_fence(__ATOMIC_ACQUIRE, "agent");
      asm volatile("s_waitcnt vmcnt(0)" ::: "memory");
    }
  }
  __syncthreads();
}

__device__ __forceinline__ void gsync(cg::grid_group& g) {
  asm volatile("s_waitcnt vmcnt(0)" ::: "memory");
  __syncthreads();
  g.sync();
  __builtin_amdgcn_fence(__ATOMIC_ACQUIRE, "agent");
  asm volatile("s_waitcnt vmcnt(0)" ::: "memory");
}

#ifdef PROBE_MASK
#define XBAR() xcd_barrier(xb, p.ws)
#define PB(id) if ((PROBE_MASK >> (id)) & 1) { pt0 = __builtin_amdgcn_s_memrealtime(); }
#define PE(id) if ((PROBE_MASK >> (id)) & 1) { pacc += __builtin_amdgcn_s_memrealtime() - pt0; }
#define PXB() xcd_barrier(xb, p.ws)
#else
#define XBAR() xcd_barrier(xb, p.ws)
#define PB(id)
#define PE(id)
#define PXB()
#endif
__global__ void __launch_bounds__(NTHR, 2) hymba_fwd(Params p) {
  cg::grid_group grid = cg::this_grid();
  __shared__ __attribute__((aligned(16))) char smem_c[73728];
  float* smem = (float*)smem_c;
  __shared__ uint4 xb_words;
  if (threadIdx.x == 0) xb_words = make_uint4(0u, 0u, 0u, 0u);
  __syncthreads();
  const XcdBarrier xb = xcd_barrier_post((unsigned*)(p.ws + OFF_BAR), (volatile LAS unsigned*)&xb_words);
  unsigned long long pt0 = 0, pacc = 0; (void)pt0; (void)pacc;
  PB(13) phase_mod(p, smem);
  phase_prologue_weights(p, smem);
  if (p.ws == nullptr) gsync(grid);
  XBAR(); PE(13)
#pragma unroll 1
  for (int l = 0; l < NL; ++l) {
    const float* modl = WSF(MOD) + (size_t)l * 2 * 6 * D;
    PB(1) phase_norm_mod(WSF(XCUR), p.norm1_g + l * D, modl + 1 * D, modl + 0 * D, nullptr, WSH(HB));
    XBAR(); PE(1)
    PB(2) gemm_bf16<NINP>(WSH(HB), WSH(WINT) + (size_t)l * NINP * D, EpiInProj{WSF(PROJ), WSH(MQK), WSH(MKT), WSH(MVT), WSH(SQK), WSH(SKT), WSH(SVT)}, smem_c);
    XBAR(); PE(2)
    PB(3) phase_ssd_conv(p, l, smem);
    XBAR(); PE(3)
    PB(4) phase_ssd_states(p, smem); PXB(); PE(4)
    PB(18) phase_moba_gate(p);
    XBAR(); PE(18)
    PB(6) phase_ssd_scan(p); PXB(); PE(6)
    PB(14) phase_attn2(p, l, smem_c);
    XBAR(); PE(14)
    PB(7) phase_ssd_y(p, l, smem);
    XBAR(); PE(7)
    PB(8) phase_mix_norm(p, l);
    XBAR(); PE(8)
    PB(9) gemm_bf16<D>(WSH(YCATB), WSH(WOUTT) + (size_t)l * D * D, EpiResid{WSF(XCUR), modl + 2 * D}, smem_c);
    XBAR(); PE(9)
    PB(1) phase_norm_mod(WSF(XCUR), p.norm2_g + l * D, modl + 4 * D, modl + 3 * D, nullptr, WSH(HB));
    XBAR(); PE(1)
    PB(10) gemm_bf16<2048>(WSH(HB), WSH(WQT) + (size_t)l * 2048 * D, EpiStoreBf16{WSH(QB), 2048}, smem_c);
    XBAR(); PE(10)
    PB(11) phase_peer_topk2(p, l, smem_c);
    XBAR(); PE(11)
    PB(12) {
      const PeerDist dist = peer_dist(xb_xcc_id(), xb_words.x, xb_words.y, xb_words.z, TIDX >> 6);
      PB(15) phase_peer_u(p, l, dist);
      XBAR(); PE(15)
      PB(16) phase_peer_r(p, l);
      XBAR(); PE(16)
      PB(17) phase_peer_v(p, l, dist);
    }
    XBAR(); PE(17) PE(12)
  }
  phase_final(p);
#ifdef PROBE_MASK
  if (blockIdx.x == 0) { const unsigned long long t0 = __builtin_amdgcn_s_memrealtime(); while (__builtin_amdgcn_s_memrealtime() - t0 < pacc) __builtin_amdgcn_s_sleep(8); }
#endif
}

extern "C" void kernel_launch(void* const* d_in, const int* in_sizes, int n_in, void* d_out, int out_size, void* d_ws, size_t ws_size, hipStream_t stream) {
  static int grid_blocks = 0;
  if (!grid_blocks) {
    int dev = 0, cus = 0, per_cu = 0;
    hipGetDevice(&dev);
    hipDeviceGetAttribute(&cus, hipDeviceAttributeMultiprocessorCount, dev);
    hipOccupancyMaxActiveBlocksPerMultiprocessor(&per_cu, hymba_fwd, NTHR, 0);
    if (per_cu > 4) per_cu = 4;
    if (per_cu < 1) per_cu = 1;
    grid_blocks = cus * per_cu;
  }
  Params p;
  memset(&p, 0, sizeof(p));
  const float** ins = (const float**)&p;
  for (int i = 0; i < 23; ++i) ins[i] = (const float*)d_in[i];
  p.out = (float*)d_out;
  p.ws = (char*)d_ws;
  if (ws_size < WS_TOTAL2) fprintf(stderr, "workspace too small: %zu < %zu\n", ws_size, WS_TOTAL);
  hipMemsetAsync(p.ws + OFF_BAR, 0, XCD_BAR_WORDS * 4, stream);
  void* args[] = {&p};
  hipError_t e = hipLaunchCooperativeKernel((void*)hymba_fwd, dim3(grid_blocks), dim3(NTHR), args, 0, stream);
  if (e != hipSuccess) fprintf(stderr, "cooperative launch failed: %s (grid %d)\n", hipGetErrorString(e), grid_blocks);
}
```

```cpp
#include <hip/hip_runtime.h>
#include <hip/hip_cooperative_groups.h>
#include <cstdio>
#include <cstdint>
#include <cstring>
namespace cg = cooperative_groups;

constexpr int D = 1024, NB = 2, S = 8192, T = NB * S, NL = 4;
constexpr int NIN = 2824;
constexpr int C_Z = 0, C_XBC = 512, C_DT = 1536, C_MQ = 1544, C_MK = 1800, C_MV = 2056, C_SQ = 2312, C_SK = 2568, C_SV = 2696;
constexpr int NTHR = 256;

struct Params {
  const float *x, *c, *ada_w, *ada_b, *norm1_g, *norm2_g, *w_in, *conv_w, *conv_b, *dt_bias, *a_log, *d_skip,
      *ssd_norm_g, *moba_norm_g, *swa_sinks, *swa_norm_g, *w_out, *peer_wq, *peer_k1, *peer_k2, *peer_u, *peer_v, *final_g;
  float* out;
  char* ws;
};
constexpr size_t al256(size_t x) { return (x + 255) & ~(size_t)255; }
constexpr size_t OFF_MOD = 0;
constexpr size_t OFF_KMEAN = OFF_MOD + al256((size_t)NL * 2 * 6 * D * 4);
constexpr size_t OFF_XCUR = OFF_KMEAN + al256((size_t)NB * 4 * 32 * 64 * 4);
constexpr size_t OFF_H = OFF_XCUR + al256((size_t)T * D * 4);
constexpr size_t OFF_PROJ = OFF_H + al256((size_t)T * D * 4);
constexpr size_t OFF_DTB = OFF_PROJ + al256((size_t)T * NIN * 4);
constexpr size_t OFF_ACS = OFF_DTB + al256((size_t)T * 8 * 4);
constexpr size_t OFF_YBUF = OFF_ACS + al256((size_t)T * 8 * 4);
constexpr size_t OFF_STATES = OFF_YBUF + al256((size_t)T * 512 * 4);
constexpr size_t OFF_YCAT = OFF_STATES + al256((size_t)NB * 64 * 8 * 64 * 128 * 4);
constexpr size_t OFF_EIDX = OFF_YCAT + al256((size_t)T * 1024 * 4);
constexpr size_t OFF_GVAL = OFF_EIDX + al256((size_t)T * 128 * 4);
constexpr int NINP = 2944;
constexpr size_t OFF_HB = OFF_GVAL + al256((size_t)T * 128 * 4);
constexpr size_t OFF_YCATB = OFF_HB + al256((size_t)T * D * 2);
constexpr size_t OFF_WINT = OFF_YCATB + al256((size_t)T * D * 2);
constexpr size_t OFF_WOUTT = OFF_WINT + al256((size_t)NL * NINP * D * 2);
constexpr size_t OFF_WQT = OFF_WOUTT + al256((size_t)NL * D * D * 2);
constexpr size_t OFF_UB = OFF_WQT + al256((size_t)NL * 2048 * D * 2);
constexpr size_t OFF_VB = OFF_UB + al256((size_t)NL * 16384 * D);
constexpr size_t OFF_K12B = OFF_VB + al256((size_t)NL * 16384 * D);
constexpr size_t WS_TOTAL = OFF_K12B + al256((size_t)NL * 2 * 128 * 128 * 2);
constexpr size_t OFF_MQK = WS_TOTAL;
constexpr size_t OFF_MVT = OFF_MQK + al256((size_t)T * 512 * 2);
constexpr size_t OFF_SQK = OFF_MVT + al256((size_t)T * 256 * 2);
constexpr size_t OFF_SVT = OFF_SQK + al256((size_t)T * 384 * 2);
constexpr size_t OFF_MSEL = OFF_SVT + al256((size_t)T * 128 * 2);
constexpr size_t OFF_MKT = OFF_MSEL + al256((size_t)T * 4 * 4);
constexpr size_t OFF_SKT = OFF_MKT + al256((size_t)T * 256 * 2);
constexpr size_t OFF_BCTOK = OFF_SKT + al256((size_t)T * 128 * 2);
constexpr size_t OFF_XBT = OFF_BCTOK + al256((size_t)T * 512 * 2);
constexpr size_t OFF_SINB = OFF_XBT + al256((size_t)NB * 768 * S * 2);
constexpr size_t OFF_SUV = OFF_SINB + al256((size_t)NB * 64 * 8 * 64 * 128 * 2);
constexpr size_t OFF_PARTO = OFF_SUV + al256((size_t)NL * 2 * 16384 * 4);
constexpr size_t OFF_PARTML = OFF_PARTO + al256((size_t)T * 16 * 64 * 4);
constexpr size_t OFF_BAR = OFF_PARTML + al256((size_t)T * 16 * 2 * 4);
constexpr size_t WS_TOTAL2 = OFF_BAR + 16384;
constexpr size_t OFF_QB = OFF_PROJ;
constexpr size_t OFF_PP = OFF_PROJ + ((size_t)64 << 20);
constexpr size_t OFF_ACT = OFF_PP + (size_t)8 * T * 128 * 4;
static_assert(OFF_ACT + (size_t)T * 128 * 4 <= OFF_PROJ + al256((size_t)T * NIN * 4), "PP/ACT must fit inside the proj region");
#define WSF(name) ((float*)(p.ws + OFF_##name))
#define WSI(name) ((int*)(p.ws + OFF_##name))
#define WSH(name) ((bf16_t*)(p.ws + OFF_##name))
typedef unsigned short bf16_t;
typedef short bf16x8 __attribute__((ext_vector_type(8)));
typedef short bf16x4 __attribute__((ext_vector_type(4)));
typedef float f32x4 __attribute__((ext_vector_type(4)));
typedef float f32x16 __attribute__((ext_vector_type(16)));
typedef __bf16 hwbf2 __attribute__((ext_vector_type(2)));
typedef float f32v2 __attribute__((ext_vector_type(2)));
__device__ __forceinline__ unsigned pack2bf(float lo, float hi) { const f32v2 v = {lo, hi}; const hwbf2 b = __builtin_convertvector(v, hwbf2); return *(const unsigned*)&b; }
__device__ __forceinline__ bf16_t f2bf(float f) { return (bf16_t)(pack2bf(f, 0.f) & 0xffffu); }
__device__ __forceinline__ float bflo(unsigned w) { return __uint_as_float(w << 16); }
__device__ __forceinline__ float bfhi(unsigned w) { return __uint_as_float(w & 0xffff0000u); }

__device__ __forceinline__ int opaque_tid() { int t = threadIdx.x; asm volatile("" : "+v"(t)); return t; }
#define TIDX opaque_tid()
__device__ __forceinline__ float siluf(float x) { return x / (1.f + expf(-x)); }
__device__ __forceinline__ float wave_sum(float v) {
#pragma unroll
  for (int o = 32; o > 0; o >>= 1) v += __shfl_xor(v, o);
  return v;
}
__device__ __forceinline__ void wave_argmax(float& v, int& i) {
#pragma unroll
  for (int o = 32; o > 0; o >>= 1) {
    float ov = __shfl_xor(v, o);
    int oi = __shfl_xor(i, o);
    if (ov > v || (ov == v && oi < i)) { v = ov; i = oi; }
  }
}

__device__ __forceinline__ void phase_mod(const Params& p, float* smem) {
  for (int i = TIDX; i < NB * D; i += NTHR) smem[i] = siluf(p.c[i]);
  __syncthreads();
  const int gtid = blockIdx.x * NTHR + TIDX, gsz = gridDim.x * NTHR;
  {
    float* red = smem + 2 * D;
    const int jl = TIDX & 63, ks = TIDX >> 6;
    for (int cb = blockIdx.x; cb < NL * 6 * D / 64; cb += gridDim.x) {
      const int idx = cb * 64 + jl, l = idx / (6 * D), j = idx % (6 * D);
      const float* w = p.ada_w + (size_t)l * D * 6 * D + j + (size_t)(ks * 256) * 6 * D;
      float a0 = 0.f, a1 = 0.f;
#pragma unroll 16
      for (int k = 0; k < 256; ++k) { const float wv = w[(size_t)k * 6 * D]; a0 += smem[ks * 256 + k] * wv; a1 += smem[D + ks * 256 + k] * wv; }
      __syncthreads();
      red[(ks * 64 + jl) * 2] = a0; red[(ks * 64 + jl) * 2 + 1] = a1;
      __syncthreads();
      if (ks == 0) {
        const float bb = p.ada_b[l * 6 * D + j];
        WSF(MOD)[(l * 2 + 0) * 6 * D + j] = red[jl * 2] + red[(64 + jl) * 2] + red[(128 + jl) * 2] + red[(192 + jl) * 2] + bb;
        WSF(MOD)[(l * 2 + 1) * 6 * D + j] = red[jl * 2 + 1] + red[(64 + jl) * 2 + 1] + red[(128 + jl) * 2 + 1] + red[(192 + jl) * 2 + 1] + bb;
      }
    }
  }
  const float4* xs = (const float4*)p.x; float4* xd = (float4*)WSF(XCUR);
  for (int i = gtid; i < T * D / 4; i += gsz) xd[i] = xs[i];
  __syncthreads();
}

#define LAS __attribute__((address_space(3)))
template <int RT16> __host__ __device__ __forceinline__ size_t gt_off(int row, int k) {
  const int sub = row >> 4, tile = sub / RT16, st = sub % RT16;
  int ob = (row & 15) * 64 + (k & 31) * 2;
  ob ^= ((ob >> 9) & 1) << 5;
  return ((size_t)(tile * 32 + (k >> 5)) * RT16 + st) * 512 + (size_t)(ob >> 1);
}
__device__ __forceinline__ void phase_norm_mod(const float* xin, const float* g, const float* sc, const float* sh, float* hout, bf16_t* hb) {
  const int wave = (blockIdx.x * NTHR + TIDX) >> 6, nw = gridDim.x * (NTHR / 64), lane = TIDX & 63;
  float4 g4[4];
#pragma unroll
  for (int i = 0; i < 4; ++i) g4[i] = *(const float4*)(g + (lane + 64 * i) * 4);
  for (int t0 = wave; t0 < T; t0 += 2 * nw) {
    const int t1 = (t0 + nw < T) ? t0 + nw : t0;
    float4 va[4], vb[4]; float sa = 0.f, sb = 0.f;
#pragma unroll
    for (int i = 0; i < 4; ++i) { va[i] = ((const float4*)(xin + (size_t)t0 * D))[lane + 64 * i]; vb[i] = ((const float4*)(xin + (size_t)t1 * D))[lane + 64 * i]; }
#pragma unroll
    for (int i = 0; i < 4; ++i) {
      sa += va[i].x * va[i].x + va[i].y * va[i].y + va[i].z * va[i].z + va[i].w * va[i].w;
      sb += vb[i].x * vb[i].x + vb[i].y * vb[i].y + vb[i].z * vb[i].z + vb[i].w * vb[i].w;
    }
#pragma unroll
    for (int of = 32; of > 0; of >>= 1) { sa += __shfl_xor(sa, of); sb += __shfl_xor(sb, of); }
    const float ia = rsqrtf(sa * (1.f / D) + 1e-5f), ib = rsqrtf(sb * (1.f / D) + 1e-5f);
#define NM_EMIT(tt, vv, inv_) do { const int b_ = (tt) / S; \
      _Pragma("unroll") for (int i = 0; i < 4; ++i) { \
        const int col = (lane + 64 * i) * 4; \
        const float4 sc4 = *(const float4*)(sc + b_ * 6 * D + col), sh4 = *(const float4*)(sh + b_ * 6 * D + col); \
        float4 o; \
        o.x = vv[i].x * (inv_) * g4[i].x * (1.f + sc4.x) + sh4.x; \
        o.y = vv[i].y * (inv_) * g4[i].y * (1.f + sc4.y) + sh4.y; \
        o.z = vv[i].z * (inv_) * g4[i].z * (1.f + sc4.z) + sh4.z; \
        o.w = vv[i].w * (inv_) * g4[i].w * (1.f + sc4.w) + sh4.w; \
        if (hout) ((float4*)(hout + (size_t)(tt) * D))[lane + 64 * i] = o; \
        *(uint2*)(hb + gt_off<16>((tt), col)) = make_uint2(pack2bf(o.x, o.y), pack2bf(o.z, o.w)); \
      } } while (0)
    NM_EMIT(t0, va, ia);
    if (t1 != t0) NM_EMIT(t1, vb, ib);
#undef NM_EMIT
  }
}

__device__ __forceinline__ void transpose_cvt(const float* __restrict__ W, int K, int N, int Npad, bf16_t* __restrict__ Bt, float* smem) {
  float (*tile)[65] = (float (*)[65])smem;
  const int tk = K / 64, tn = Npad / 64, tid = TIDX;
  for (int t = blockIdx.x; t < tk * tn; t += gridDim.x) {
    const int k0 = (t / tn) * 64, n0 = (t % tn) * 64;
    __syncthreads();
#pragma unroll
    for (int r = 0; r < 16; ++r) {
      const int k = r * 4 + (tid >> 6), n = tid & 63;
      tile[k][n] = (n0 + n < N) ? W[(size_t)(k0 + k) * N + n0 + n] : 0.f;
    }
    __syncthreads();
#pragma unroll
    for (int r = 0; r < 16; ++r) {
      const int n = r * 4 + (tid >> 6), k = tid & 63;
      Bt[gt_off<8>(n0 + n, k0 + k)] = f2bf(tile[k][n]);
    }
  }
  __syncthreads();
}
__device__ __forceinline__ void phase_prologue_weights(const Params& p, float* smem) {
  for (int l = 0; l < NL; ++l) {
    transpose_cvt(p.w_in + (size_t)l * D * NIN, D, NIN, NINP, WSH(WINT) + (size_t)l * NINP * D, smem);
    transpose_cvt(p.w_out + (size_t)l * D * D, D, D, D, WSH(WOUTT) + (size_t)l * D * D, smem);
    transpose_cvt(p.peer_wq + (size_t)l * D * 2048, D, 2048, 2048, WSH(WQT) + (size_t)l * 2048 * D, smem);
  }
  const int gtid = blockIdx.x * NTHR + TIDX, gsz = gridDim.x * NTHR;
  for (int i = gtid; i < NL * 2 * 128 * 128; i += gsz) {
    const int l = i / 32768, r = i % 32768;
    WSH(K12B)[i] = f2bf(r < 16384 ? p.peer_k1[l * 16384 + r] : p.peer_k2[l * 16384 + r - 16384]);
  }
  {
    const int lane = TIDX & 63, gw = (blockIdx.x * NTHR + TIDX) >> 6, nw = gridDim.x * (NTHR / 64);
    for (int row = gw; row < 2 * NL * 16384; row += nw) {
      const int which = row / (NL * 16384), r = row % (NL * 16384);
      const float4* src4 = (const float4*)((which ? p.peer_v : p.peer_u) + (size_t)r * D) + lane * 4;
      const float4 a = src4[0], b = src4[1], c = src4[2], d = src4[3];
      float m = fmaxf(fmaxf(fmaxf(fabsf(a.x), fabsf(a.y)), fmaxf(fabsf(a.z), fabsf(a.w))), fmaxf(fmaxf(fabsf(b.x), fabsf(b.y)), fmaxf(fabsf(b.z), fabsf(b.w))));
      m = fmaxf(m, fmaxf(fmaxf(fmaxf(fabsf(c.x), fabsf(c.y)), fmaxf(fabsf(c.z), fabsf(c.w))), fmaxf(fmaxf(fabsf(d.x), fabsf(d.y)), fmaxf(fabsf(d.z), fabsf(d.w)))));
#pragma unroll
      for (int o = 32; o > 0; o >>= 1) m = fmaxf(m, __shfl_xor(m, o));
      const float sc = m > 0.f ? m * (1.f / 240.f) : 1.f, inv = 1.f / sc;
      int w0 = 0, w1 = 0, w2 = 0, w3 = 0;
      w0 = __builtin_amdgcn_cvt_pk_fp8_f32(a.x * inv, a.y * inv, w0, false); w0 = __builtin_amdgcn_cvt_pk_fp8_f32(a.z * inv, a.w * inv, w0, true);
      w1 = __builtin_amdgcn_cvt_pk_fp8_f32(b.x * inv, b.y * inv, w1, false); w1 = __builtin_amdgcn_cvt_pk_fp8_f32(b.z * inv, b.w * inv, w1, true);
      w2 = __builtin_amdgcn_cvt_pk_fp8_f32(c.x * inv, c.y * inv, w2, false); w2 = __builtin_amdgcn_cvt_pk_fp8_f32(c.z * inv, c.w * inv, w2, true);
      w3 = __builtin_amdgcn_cvt_pk_fp8_f32(d.x * inv, d.y * inv, w3, false); w3 = __builtin_amdgcn_cvt_pk_fp8_f32(d.z * inv, d.w * inv, w3, true);
      {
        const int l_ = r / 16384, e_ = r % 16384;
        *(uint4*)(p.ws + (which ? OFF_VB : OFF_UB) + (((size_t)(l_ * 8 + (lane >> 3)) * 16384 + e_) * 128 + (lane & 7) * 16)) = make_uint4((unsigned)w0, (unsigned)w1, (unsigned)w2, (unsigned)w3);
      }
      if (lane == 0) {
        const int l = r / 16384, e = r % 16384;
        WSF(SUV)[(l * 2 + which) * 16384 + e] = sc;
      }
    }
  }
}

struct EpiStoreF32 {
  float* C; int ldc, N;
  __device__ __forceinline__ void operator()(int m, int n, f32x4 v) const { if (n < N) *(f32x4*)(C + (size_t)m * ldc + n) = v; }
};

__host__ __device__ __forceinline__ size_t ktile_off(int bh, int s, int d) {
  return ((((size_t)bh * 128 + (s >> 6)) * 2 + ((s >> 5) & 1)) * 4 + (d >> 4)) * 512 + (size_t)(((s & 31) + 32 * ((d >> 3) & 1)) * 8 + (d & 7));
}
__host__ __device__ __forceinline__ size_t vtile_off(int bh, int d, int s) {
  const int kk = s & 63, ks = ((kk >> 5) << 1) | ((kk >> 4) & 1), piece = (kk >> 3) & 1, h = (kk >> 2) & 1;
  return ((((((size_t)bh * 128 + (s >> 6)) * 4 + ks) * 2 + piece) * 2 + (d >> 5)) * 64 + ((d & 31) + 32 * h)) * 4 + (kk & 3);
}
struct EpiInProj {
  float* C; bf16_t *mqk, *mkt, *mvt, *sqk, *skt, *svt;
  __device__ __forceinline__ void operator()(int m, int n, f32x4 v) const {
    if (n >= NIN) return;
    if (n < C_MV) *(f32x4*)(C + (size_t)m * NIN + n) = v;
    if (n < C_MQ) return;
    const int b = m / S, s = m & (S - 1);
    const uint2 pk = make_uint2(pack2bf(v[0], v[1]), pack2bf(v[2], v[3]));
    if (n < C_MK) { *(uint2*)(mqk + (size_t)m * 512 + (n - C_MQ)) = pk; }
    else if (n < C_MV) { const int c = n - C_MK; *(uint2*)(mkt + ktile_off(b * 4 + (c >> 6), s, c & 63)) = pk; }
    else if (n < C_SQ) { const int c = n - C_MV, bh = b * 4 + (c >> 6), d = c & 63;
      mvt[vtile_off(bh, d, s)] = (bf16_t)(pk.x & 0xffff); mvt[vtile_off(bh, d + 1, s)] = (bf16_t)(pk.x >> 16); mvt[vtile_off(bh, d + 2, s)] = (bf16_t)(pk.y & 0xffff); mvt[vtile_off(bh, d + 3, s)] = (bf16_t)(pk.y >> 16); }
    else if (n < C_SK) { *(uint2*)(sqk + (size_t)m * 384 + (n - C_SQ)) = pk; }
    else if (n < C_SV) { const int c = n - C_SK; *(uint2*)(skt + ktile_off(b * 2 + (c >> 6), s, c & 63)) = pk; }
    else { const int c = n - C_SV, bh = b * 2 + (c >> 6), d = c & 63;
      svt[vtile_off(bh, d, s)] = (bf16_t)(pk.x & 0xffff); svt[vtile_off(bh, d + 1, s)] = (bf16_t)(pk.x >> 16); svt[vtile_off(bh, d + 2, s)] = (bf16_t)(pk.y & 0xffff); svt[vtile_off(bh, d + 3, s)] = (bf16_t)(pk.y >> 16); }
  }
};
struct EpiStoreBf16 {
  bf16_t* C; int ldc;
  __device__ __forceinline__ void operator()(int m, int n, f32x4 v) const { *(uint2*)(C + (size_t)m * ldc + n) = make_uint2(pack2bf(v[0], v[1]), pack2bf(v[2], v[3])); }
};
struct EpiResid {
  float* X; const float* gate;
  __device__ __forceinline__ void operator()(int m, int n, f32x4 v) const {
    const f32x4 g = *(const f32x4*)(gate + (m / S) * 6 * D + n);
    f32x4* xp = (f32x4*)(X + (size_t)m * D + n);
    f32x4 o = *xp; o += g * v; *xp = o;
  }
};
__device__ __forceinline__ void glds16(const void* gsrc, unsigned lds_dst) {
  unsigned keep;
  lds_dst = __builtin_amdgcn_readfirstlane(lds_dst);
  asm volatile("s_mov_b32 %0, m0\n\ts_mov_b32 m0, %2\n\ts_nop 0\n\tglobal_load_lds_dwordx4 %1, off\n\ts_mov_b32 m0, %0" : "=&s"(keep) : "v"(gsrc), "s"(lds_dst) : "memory");
}
template <int NPAD, class Epi>
__device__ __forceinline__ void gemm_bf16(const bf16_t* __restrict__ A, const bf16_t* __restrict__ Bt, const Epi epi, char* smem) {
  const int tid = TIDX, lane = tid & 63, wid = tid >> 6, wr = wid >> 1, wc = wid & 1;
  constexpr int tilesN = NPAD / 128, tilesM = T / 256, ntiles = tilesM * tilesN, nk = D / 32, nig = 4 * tilesN;
  static_assert(tilesM % 4 == 0 && ntiles % 8 == 0 && nk % 2 == 0, "raster");
  int q0, qstep, nmy;
  { const int G = (int)gridDim.x, b = (int)blockIdx.x;
    if ((G & 15) == 0) { const int R = G >> 3, x = b & 7, r = b >> 3, pos = (r % (R >> 1)) * 2 + r / (R >> 1); constexpr int per = ntiles / 8;
      q0 = x * per + pos; qstep = R; nmy = (pos < per) ? (per - 1 - pos) / R + 1 : 0; }
    else { q0 = b; qstep = G; nmy = (b < ntiles) ? (ntiles - 1 - b) / G + 1 : 0; } }
  const int total = nmy * nk;
  if (total == 0) return;
  const unsigned lds0 = __builtin_amdgcn_readfirstlane((unsigned)(size_t)(LAS char*)smem);
  int fo = (lane & 15) * 64 + (lane >> 4) * 16;
  fo ^= ((fo >> 9) & 1) << 5;
  const int fa0 = wr * 8192 + fo, fb0 = 16384 + wc * 4096 + fo;
  f32x4 acc[8][4];
#pragma unroll
  for (int i = 0; i < 8; ++i)
#pragma unroll
    for (int j = 0; j < 4; ++j) acc[i][j] = (f32x4){0.f, 0.f, 0.f, 0.f};
#define TILEQ(s) const int q_ = q0 + ((s) / nk) * qstep, gid_ = q_ / nig, rem_ = q_ - gid_ * nig, tm_ = gid_ * 4 + (rem_ & 3), tn_ = rem_ >> 2;
#define GSTAGE(buf, s) do { TILEQ(s) \
      const bf16_t* Ag = A + (size_t)(tm_ * 32 + ((s) % nk)) * 8192 + wid * 2048 + lane * 8; \
      const bf16_t* Bg = Bt + (size_t)(tn_ * 32 + ((s) % nk)) * 4096 + wid * 1024 + lane * 8; \
      const unsigned la_ = lds0 + (buf) + wid * 4096, lb_ = lds0 + (buf) + 16384 + wid * 2048; \
      glds16(Ag, la_); glds16(Ag + 512, la_ + 1024); glds16(Ag + 1024, la_ + 2048); glds16(Ag + 1536, la_ + 3072); \
      glds16(Bg, lb_); glds16(Bg + 512, lb_ + 1024); } while (0)
#define MM(mi, ni, a, b) acc[mi][ni] = __builtin_amdgcn_mfma_f32_16x16x32_bf16(b, a, acc[mi][ni], 0, 0, 0)
#define MROW(mi, af) do { MM(mi, 0, af, bf0); MM(mi, 1, af, bf1); MM(mi, 2, af, bf2); MM(mi, 3, af, bf3); } while (0)
#define AFR(mi, cur) *(const bf16x8*)(smem + (cur) + fa0 + (mi) * 1024)
#define SB __builtin_amdgcn_sched_barrier(0)
#define COMPUTE(cur) do { \
        const bf16x8 bf0 = *(const bf16x8*)(smem + (cur) + fb0); \
        const bf16x8 bf1 = *(const bf16x8*)(smem + (cur) + fb0 + 1024); \
        const bf16x8 bf2 = *(const bf16x8*)(smem + (cur) + fb0 + 2048); \
        const bf16x8 bf3 = *(const bf16x8*)(smem + (cur) + fb0 + 3072); \
        const bf16x8 af0 = AFR(0, cur), af1 = AFR(1, cur); SB; \
        const bf16x8 af2 = AFR(2, cur); MROW(0, af0); SB; \
        const bf16x8 af3 = AFR(3, cur); MROW(1, af1); SB; \
        const bf16x8 af4 = AFR(4, cur); MROW(2, af2); SB; \
        const bf16x8 af5 = AFR(5, cur); MROW(3, af3); SB; \
        const bf16x8 af6 = AFR(6, cur); MROW(4, af4); SB; \
        const bf16x8 af7 = AFR(7, cur); MROW(5, af5); SB; \
        MROW(6, af6); MROW(7, af7); SB; } while (0)
  __syncthreads();
  GSTAGE(0, 0);
  GSTAGE(24576, 1);
  int cur = 0, prev = 49152;
#pragma unroll 1
  for (int s = 0; s < total; ++s) {
    if (s + 1 < total) asm volatile("s_waitcnt vmcnt(6)" ::: "memory"); else asm volatile("s_waitcnt vmcnt(0)" ::: "memory");
    asm volatile("s_waitcnt lgkmcnt(0)\n\ts_barrier" ::: "memory");
    if (s + 2 < total) GSTAGE(prev, s + 2);
    COMPUTE(cur);
    if (s % nk == nk - 1) {
      TILEQ(s) const int tm = tm_, tn = tn_;
#pragma unroll
      for (int mi = 0; mi < 8; ++mi)
#pragma unroll
        for (int ni = 0; ni < 4; ++ni) {
          epi(tm * 256 + wr * 128 + mi * 16 + (lane & 15), tn * 128 + wc * 64 + ni * 16 + (lane >> 4) * 4, acc[mi][ni]);
          acc[mi][ni] = (f32x4){0.f, 0.f, 0.f, 0.f};
        }
    }
    prev = cur; cur = (cur == 49152) ? 0 : cur + 24576;
  }
  __syncthreads();
#undef TILEQ
#undef GSTAGE
#undef MM
#undef MROW
#undef AFR
#undef SB
#undef COMPUTE
}


__host__ __device__ __forceinline__ size_t bct_off(int t, int cc) {
  const int n = cc & 127;
  return ((((size_t)(t >> 5) * 4 + (cc >> 7)) * 8 + (n >> 4)) * 64 + ((t & 31) + 32 * ((n >> 3) & 1))) * 8 + (n & 7);
}
__host__ __device__ __forceinline__ size_t xbt_off(int b, int ch, int s) {
  const int kk = s & 127, rem = kk & 31;
  size_t o = (size_t)(b * 64 + (s >> 7));
  o = o * 24 + (ch >> 5);
  o = o * 4 + (kk >> 5);
  o = o * 2 + (rem >> 4);
  o = o * 2 + ((rem >> 3) & 1);
  o = o * 64 + ((ch & 31) + 32 * ((rem >> 2) & 1));
  return o * 4 + (rem & 3);
}
__device__ __forceinline__ void phase_ssd_conv(const Params& p, int l, float* smem) {
  const int tid = TIDX, lane = tid & 63, wv = tid >> 6;
  float (*xin)[64] = (float (*)[64])smem;
  float (*ot)[65] = (float (*)[65])(smem + 67 * 64);
  const float* cw = p.conv_w + l * 4 * 1024; const float* cbv = p.conv_b + l * 1024;
  float4 r0, r1, r2, r3, r4;
#define CONV_ONE(R, k, tl) do { const int i_ = tid + (k) * NTHR, row_ = i_ >> 4, c4_ = (i_ & 15) * 4; \
      const int t0_ = ((tl) >> 4) * 64, ch0_ = ((tl) & 15) * 64, s0_ = t0_ & (S - 1); \
      R = make_float4(0.f, 0.f, 0.f, 0.f); \
      if (i_ < 67 * 16 && s0_ + row_ - 3 >= 0) R = *(const float4*)(WSF(PROJ) + (size_t)(t0_ + row_ - 3) * NIN + C_XBC + ch0_ + c4_); } while (0)
#define CONV_FETCH(tl) do { CONV_ONE(r0, 0, tl); CONV_ONE(r1, 1, tl); CONV_ONE(r2, 2, tl); CONV_ONE(r3, 3, tl); CONV_ONE(r4, 4, tl); } while (0)
#define CONV_PUT(R, k) do { const int i_ = tid + (k) * NTHR; if (i_ < 67 * 16) *(float4*)&xin[i_ >> 4][(i_ & 15) * 4] = R; } while (0)
  if ((int)blockIdx.x < 256 * 16) CONV_FETCH((int)blockIdx.x);
  for (int tile = blockIdx.x; tile < 256 * 16; tile += gridDim.x) {
    const int tt = tile >> 4, ct = tile & 15, t0 = tt * 64, ch0 = ct * 64, s0 = t0 & (S - 1), b = t0 / S;
    __syncthreads();
    CONV_PUT(r0, 0); CONV_PUT(r1, 1); CONV_PUT(r2, 2); CONV_PUT(r3, 3); CONV_PUT(r4, 4);
    if (tile + (int)gridDim.x < 256 * 16) CONV_FETCH(tile + (int)gridDim.x);
    __syncthreads();
    {
      const int ch = ch0 + lane;
      const float w0 = cw[ch], w1 = cw[1024 + ch], w2 = cw[2048 + ch], w3 = cw[3072 + ch], bb = cbv[ch];
      float x0 = xin[wv * 16 + 0][lane], x1 = xin[wv * 16 + 1][lane], x2 = xin[wv * 16 + 2][lane];
#pragma unroll
      for (int i = 0; i < 16; ++i) {
        const int tok = wv * 16 + i;
        const float x3 = xin[tok + 3][lane];
        const float v = siluf(bb + w0 * x0 + w1 * x1 + w2 * x2 + w3 * x3);
        x0 = x1; x1 = x2; x2 = x3;
        ot[tok][lane] = v;
      }
    }
    __syncthreads();
    if (ch0 >= 512) {
#pragma unroll
      for (int i = 0; i < 2; ++i) {
        const int it = tid + i * NTHR, tok = it & 63, n8 = (it >> 6) * 8;
        const float* o8 = &ot[tok][n8];
        *(uint4*)(WSH(BCTOK) + (size_t)(t0 + tok) * 512 + (ch0 - 512 + n8)) = make_uint4(pack2bf(o8[0], o8[1]), pack2bf(o8[2], o8[3]), pack2bf(o8[4], o8[5]), pack2bf(o8[6], o8[7]));
      }
    }
    if (ch0 < 768) {
#pragma unroll
      for (int i = 0; i < 4; ++i) {
        const int it = tid + i * NTHR, chl = it & 63, tk4 = (it >> 6) * 4;
        *(uint2*)(WSH(XBT) + xbt_off(b, ch0 + chl, s0 + tk4)) = make_uint2(pack2bf(ot[tk4][chl], ot[tk4 + 1][chl]), pack2bf(ot[tk4 + 2][chl], ot[tk4 + 3][chl]));
      }
    }
  }
#undef CONV_ONE
#undef CONV_FETCH
#undef CONV_PUT
  __syncthreads();
  const int gw = (blockIdx.x * NTHR + tid) >> 6, nw = gridDim.x * (NTHR / 64);
  for (int item = gw; item < NB * 64 * 8; item += nw) {
    const int hh = item & 7, bc = item >> 3;
    const float ah = -expf(p.a_log[l * 8 + hh]), bias = p.dt_bias[l * 8 + hh];
    float dtv[2], av[2];
#pragma unroll
    for (int i = 0; i < 2; ++i) {
      const int t = bc * 128 + i * 64 + lane;
      const float v = WSF(PROJ)[(size_t)t * NIN + C_DT + hh] + bias;
      dtv[i] = v > 20.f ? v : log1pf(expf(v));
      av[i] = dtv[i] * ah;
    }
#pragma unroll
    for (int o = 1; o < 64; o <<= 1) {
      const float u0 = __shfl_up(av[0], o), u1 = __shfl_up(av[1], o);
      if (lane >= o) { av[0] += u0; av[1] += u1; }
    }
    av[1] += __shfl(av[0], 63);
#pragma unroll
    for (int i = 0; i < 2; ++i) { const int t = bc * 128 + i * 64 + lane; WSF(DTB)[t * 8 + hh] = dtv[i]; WSF(ACS)[t * 8 + hh] = av[i]; }
  }
  {
    float* red = smem;
    for (int item = blockIdx.x; item < NB * 32 * 4; item += gridDim.x) {
      const int hh = item & 3, n = (item >> 2) & 31, b = item >> 7;
      const float* kp = WSF(PROJ) + (size_t)(b * S + n * 256 + wv * 64) * NIN + C_MK + hh * 64 + lane;
      float s = 0.f;
#pragma unroll 16
      for (int j = 0; j < 64; ++j) s += kp[(size_t)j * NIN];
      __syncthreads();
      red[wv * 64 + lane] = s;
      __syncthreads();
      if (wv == 0) WSF(KMEAN)[((b * 4 + hh) * 32 + n) * 64 + lane] = (red[lane] + red[64 + lane] + red[128 + lane] + red[192 + lane]) * (1.f / 256.f);
    }
  }
  __syncthreads();
}

__device__ __forceinline__ bf16x8 scale_bf8(const bf16x8 v, const float* w) {
  bf16x8 r;
#pragma unroll
  for (int j = 0; j < 4; ++j) {
    const unsigned lo = (unsigned short)v[2 * j], hi = (unsigned short)v[2 * j + 1];
    const unsigned pk = pack2bf(__uint_as_float(lo << 16) * w[2 * j], __uint_as_float(hi << 16) * w[2 * j + 1]);
    r[2 * j] = (short)(pk & 0xffff); r[2 * j + 1] = (short)(pk >> 16);
  }
  return r;
}
__device__ __forceinline__ void phase_ssd_states(const Params& p, float* smem) {
  const int tid = TIDX, lane = tid & 63, wv = tid >> 6, h = lane >> 5, r31 = lane & 31;
  float* wl = smem;
  for (int item = blockIdx.x; item < NB * 64 * 8; item += gridDim.x) {
    const int hh = item & 7, bc = item >> 3, b = bc >> 6, c = bc & 63, g = hh >> 2, t0 = bc * 128;
    __syncthreads();
    if (tid < 128) wl[tid] = expf(WSF(ACS)[(t0 + 127) * 8 + hh] - WSF(ACS)[(t0 + tid) * 8 + hh]) * WSF(DTB)[(t0 + tid) * 8 + hh];
    __syncthreads();
    const bf16_t* xa0 = WSH(XBT) + xbt_off(b, hh * 64, c * 128) + lane * 4;
    const bf16_t* xa1 = WSH(XBT) + xbt_off(b, hh * 64 + 32, c * 128) + lane * 4;
    const bf16_t* bb = WSH(XBT) + xbt_off(b, 512 + g * 128 + wv * 32, c * 128) + lane * 4;
    f32x16 acc0, acc1;
#pragma unroll
    for (int r = 0; r < 16; ++r) { acc0[r] = 0.f; acc1[r] = 0.f; }
#pragma unroll
    for (int ks = 0; ks < 8; ++ks) {
      const bf16x4 p0 = *(const bf16x4*)(xa0 + ks * 512), p1 = *(const bf16x4*)(xa0 + ks * 512 + 256);
      const bf16x4 q0 = *(const bf16x4*)(xa1 + ks * 512), q1 = *(const bf16x4*)(xa1 + ks * 512 + 256);
      const bf16x4 b0 = *(const bf16x4*)(bb + ks * 512), b1 = *(const bf16x4*)(bb + ks * 512 + 256);
      const bf16x8 a0 = (bf16x8){p0[0], p0[1], p0[2], p0[3], p1[0], p1[1], p1[2], p1[3]};
      const bf16x8 a1 = (bf16x8){q0[0], q0[1], q0[2], q0[3], q1[0], q1[1], q1[2], q1[3]};
      const float4 wlo = *(const float4*)(wl + 16 * ks + 4 * h), whi = *(const float4*)(wl + 16 * ks + 8 + 4 * h);
      const float w8[8] = {wlo.x, wlo.y, wlo.z, wlo.w, whi.x, whi.y, whi.z, whi.w};
      const bf16x8 bq = scale_bf8((bf16x8){b0[0], b0[1], b0[2], b0[3], b1[0], b1[1], b1[2], b1[3]}, w8);
      acc0 = __builtin_amdgcn_mfma_f32_32x32x16_bf16(a0, bq, acc0, 0, 0, 0);
      acc1 = __builtin_amdgcn_mfma_f32_32x32x16_bf16(a1, bq, acc1, 0, 0, 0);
    }
    float* sp = WSF(STATES) + ((size_t)item * 64) * 128 + wv * 32 + r31;
#pragma unroll
    for (int r = 0; r < 16; ++r) {
      const int pr = (r & 3) + 8 * (r >> 2) + 4 * h;
      sp[(size_t)pr * 128] = acc0[r]; sp[(size_t)(32 + pr) * 128] = acc1[r];
    }
  }
  __syncthreads();
}

__device__ __forceinline__ void phase_ssd_scan(const Params& p) {
  const int gtid = blockIdx.x * NTHR + TIDX, gsz = gridDim.x * NTHR;
  for (int idx = gtid; idx < NB * 8 * 64 * 128; idx += gsz) {
    const int pn = idx & 8191, hh = (idx >> 13) & 7, b = idx >> 16;
    float Sv = 0.f;
#pragma unroll 1
    for (int c0 = 0; c0 < 64; c0 += 8) {
      float tmp[8], dec[8];
#pragma unroll
      for (int i = 0; i < 8; ++i) {
        tmp[i] = WSF(STATES)[((size_t)((b * 64 + c0 + i) * 8 + hh)) * 8192 + pn];
        dec[i] = WSF(ACS)[(b * S + (c0 + i) * 128 + 127) * 8 + hh];
      }
#pragma unroll
      for (int i = 0; i < 8; ++i) {
        WSH(SINB)[((size_t)((b * 64 + c0 + i) * 8 + hh)) * 8192 + pn] = f2bf(Sv);
        Sv = expf(dec[i]) * Sv + tmp[i];
      }
    }
  }
}

__device__ __forceinline__ void phase_ssd_y(const Params& p, int l, float* smem) {
  const int tid = TIDX, lane = tid & 63, wv = tid >> 6, h = lane >> 5, r31 = lane & 31;
  float* acs_s = smem; float* dt_s = smem + 128;
  for (int item = blockIdx.x; item < NB * 64 * 8; item += gridDim.x) {
    const int hh = item & 7, bc = item >> 3, b = bc >> 6, c = bc & 63, g = hh >> 2, t0 = bc * 128;
    __syncthreads();
    if (tid < 128) { acs_s[tid] = WSF(ACS)[(t0 + tid) * 8 + hh]; dt_s[tid] = WSF(DTB)[(t0 + tid) * 8 + hh]; }
    __syncthreads();
    const float dsk = p.d_skip[l * 8 + hh];
    const float acs_l = acs_s[wv * 32 + r31];
    bf16x8 cf[8];
    {
      const bf16_t* cp = WSH(BCTOK) + (size_t)(t0 + wv * 32 + r31) * 512 + 256 + g * 128 + 8 * h;
#pragma unroll
      for (int ks = 0; ks < 8; ++ks) cf[ks] = *(const bf16x8*)(cp + 16 * ks);
    }
    f32x16 y0, y1;
#pragma unroll
    for (int r = 0; r < 16; ++r) { y0[r] = 0.f; y1[r] = 0.f; }
    const bf16_t* xrow = WSH(XBT) + xbt_off(b, hh * 64, c * 128) + lane * 4;
    for (int st = 0; st <= wv; ++st) {
      f32x16 G;
#pragma unroll
      for (int r = 0; r < 16; ++r) G[r] = 0.f;
      const bf16_t* bp = WSH(BCTOK) + (size_t)(t0 + st * 32 + r31) * 512 + g * 128 + 8 * h;
#pragma unroll
      for (int ks = 0; ks < 8; ++ks) G = __builtin_amdgcn_mfma_f32_32x32x16_bf16(*(const bf16x8*)(bp + 16 * ks), cf[ks], G, 0, 0, 0);
      const bool diag = (st == wv);
#pragma unroll
      for (int r = 0; r < 16; ++r) {
        const int sl = (r & 3) + 8 * (r >> 2) + 4 * h, s = st * 32 + sl;
        float v = G[r] * __expf(acs_l - acs_s[s]) * dt_s[s];
        if (diag) { v = (sl <= r31) ? v : 0.f; if (sl == r31) v += dsk; }
        G[r] = v;
      }
      bf16x8 mf[2];
#pragma unroll
      for (int q = 0; q < 2; ++q) {
        unsigned w4[4];
#pragma unroll
        for (int j = 0; j < 4; ++j) w4[j] = pack2bf(G[q * 8 + 2 * j], G[q * 8 + 2 * j + 1]);
        mf[q] = (bf16x8){(short)(w4[0] & 0xffff), (short)(w4[0] >> 16), (short)(w4[1] & 0xffff), (short)(w4[1] >> 16), (short)(w4[2] & 0xffff), (short)(w4[2] >> 16), (short)(w4[3] & 0xffff), (short)(w4[3] >> 16)};
      }
#pragma unroll
      for (int q = 0; q < 2; ++q) {
        const bf16_t* xp = xrow + (st * 2 + q) * 512;
        const bf16x4 a0 = *(const bf16x4*)xp, a1 = *(const bf16x4*)(xp + 256);
        const bf16x4 b0 = *(const bf16x4*)(xp + 4096), b1 = *(const bf16x4*)(xp + 4096 + 256);
        const bf16x8 xa0 = (bf16x8){a0[0], a0[1], a0[2], a0[3], a1[0], a1[1], a1[2], a1[3]};
        const bf16x8 xa1 = (bf16x8){b0[0], b0[1], b0[2], b0[3], b1[0], b1[1], b1[2], b1[3]};
        y0 = __builtin_amdgcn_mfma_f32_32x32x16_bf16(xa0, mf[q], y0, 0, 0, 0);
        y1 = __builtin_amdgcn_mfma_f32_32x32x16_bf16(xa1, mf[q], y1, 0, 0, 0);
      }
    }
    f32x16 z0, z1;
#pragma unroll
    for (int r = 0; r < 16; ++r) { z0[r] = 0.f; z1[r] = 0.f; }
    {
      const bf16_t* sp = WSH(SINB) + ((size_t)item * 64 + r31) * 128 + 8 * h;
#pragma unroll
      for (int ks = 0; ks < 8; ++ks) {
        z0 = __builtin_amdgcn_mfma_f32_32x32x16_bf16(*(const bf16x8*)(sp + 16 * ks), cf[ks], z0, 0, 0, 0);
        z1 = __builtin_amdgcn_mfma_f32_32x32x16_bf16(*(const bf16x8*)(sp + (size_t)32 * 128 + 16 * ks), cf[ks], z1, 0, 0, 0);
      }
    }
    const float eal = __expf(acs_l);
    float* yp = WSF(YBUF) + (size_t)(t0 + wv * 32 + r31) * 512 + hh * 64 + 4 * h;
#pragma unroll
    for (int gq = 0; gq < 4; ++gq) {
      *(float4*)(yp + gq * 8) = make_float4(y0[gq * 4 + 0] + eal * z0[gq * 4 + 0], y0[gq * 4 + 1] + eal * z0[gq * 4 + 1], y0[gq * 4 + 2] + eal * z0[gq * 4 + 2], y0[gq * 4 + 3] + eal * z0[gq * 4 + 3]);
      *(float4*)(yp + 32 + gq * 8) = make_float4(y1[gq * 4 + 0] + eal * z1[gq * 4 + 0], y1[gq * 4 + 1] + eal * z1[gq * 4 + 1], y1[gq * 4 + 2] + eal * z1[gq * 4 + 2], y1[gq * 4 + 3] + eal * z1[gq * 4 + 3]);
    }
  }
  __syncthreads();
}


__device__ __forceinline__ void phase_mix_norm(const Params& p, int l) {
  const int wave = (blockIdx.x * NTHR + TIDX) >> 6, nw = gridDim.x * (NTHR / 64), lane = TIDX & 63;
  const float4 gs0 = *(const float4*)(p.ssd_norm_g + l * 512 + lane * 4), gs1 = *(const float4*)(p.ssd_norm_g + l * 512 + 256 + lane * 4);
  const float4 gm = *(const float4*)(p.moba_norm_g + l * 256 + lane * 4), gw = *(const float4*)(p.swa_norm_g + l * 256 + lane * 4);
  const int hh = lane >> 4, d4 = (lane & 15) * 4;
  for (int t = wave; t < T; t += nw) {
    const float4 y0 = *(const float4*)(WSF(YBUF) + (size_t)t * 512 + lane * 4), y1 = *(const float4*)(WSF(YBUF) + (size_t)t * 512 + 256 + lane * 4);
    const float4 z0 = *(const float4*)(WSF(PROJ) + (size_t)t * NIN + C_Z + lane * 4), z1 = *(const float4*)(WSF(PROJ) + (size_t)t * NIN + C_Z + 256 + lane * 4);
    const float4 sw = *(const float4*)(WSF(YCAT) + (size_t)t * 1024 + 768 + lane * 4);
    const int ms = WSI(MSEL)[(size_t)t * 4 + hh];
    const size_t base = ((size_t)t * 4 + hh) * 4;
    const bool ok0 = (ms & 63) != 63, ok1 = ((ms >> 6) & 63) != 63, ok2 = ((ms >> 12) & 63) != 63;
    float2 ml[4]; float4 pv[4];
    ml[0] = ok0 ? *(const float2*)(WSF(PARTML) + (base + 0) * 2) : make_float2(-INFINITY, 0.f);
    ml[1] = ok1 ? *(const float2*)(WSF(PARTML) + (base + 1) * 2) : make_float2(-INFINITY, 0.f);
    ml[2] = ok2 ? *(const float2*)(WSF(PARTML) + (base + 2) * 2) : make_float2(-INFINITY, 0.f);
    ml[3] = *(const float2*)(WSF(PARTML) + (base + 3) * 2);
    pv[0] = ok0 ? *(const float4*)(WSF(PARTO) + (base + 0) * 64 + d4) : make_float4(0.f, 0.f, 0.f, 0.f);
    pv[1] = ok1 ? *(const float4*)(WSF(PARTO) + (base + 1) * 64 + d4) : make_float4(0.f, 0.f, 0.f, 0.f);
    pv[2] = ok2 ? *(const float4*)(WSF(PARTO) + (base + 2) * 64 + d4) : make_float4(0.f, 0.f, 0.f, 0.f);
    pv[3] = *(const float4*)(WSF(PARTO) + (base + 3) * 64 + d4);
    float4 v0, v1;
    v0.x = y0.x * siluf(z0.x); v0.y = y0.y * siluf(z0.y); v0.z = y0.z * siluf(z0.z); v0.w = y0.w * siluf(z0.w);
    v1.x = y1.x * siluf(z1.x); v1.y = y1.y * siluf(z1.y); v1.z = y1.z * siluf(z1.z); v1.w = y1.w * siluf(z1.w);
    const float M = fmaxf(fmaxf(ml[0].x, ml[1].x), fmaxf(ml[2].x, ml[3].x));
    float4 o = make_float4(0.f, 0.f, 0.f, 0.f); float L = 0.f;
#pragma unroll
    for (int sl = 0; sl < 4; ++sl) {
      const float f = __builtin_amdgcn_exp2f(ml[sl].x - M);
      o.x += pv[sl].x * f; o.y += pv[sl].y * f; o.z += pv[sl].z * f; o.w += pv[sl].w * f; L += ml[sl].y * f;
    }
    const float il = 1.f / L;
    const float4 mo = make_float4(o.x * il, o.y * il, o.z * il, o.w * il);
    float s0 = v0.x * v0.x + v0.y * v0.y + v0.z * v0.z + v0.w * v0.w + v1.x * v1.x + v1.y * v1.y + v1.z * v1.z + v1.w * v1.w;
    float s1 = mo.x * mo.x + mo.y * mo.y + mo.z * mo.z + mo.w * mo.w;
    float s2 = sw.x * sw.x + sw.y * sw.y + sw.z * sw.z + sw.w * sw.w;
#pragma unroll
    for (int of = 32; of > 0; of >>= 1) { s0 += __shfl_xor(s0, of); s1 += __shfl_xor(s1, of); s2 += __shfl_xor(s2, of); }
    const float i0 = rsqrtf(s0 * (1.f / 512.f) + 1e-5f), i1 = rsqrtf(s1 * (1.f / 256.f) + 1e-5f), i2 = rsqrtf(s2 * (1.f / 256.f) + 1e-5f);
    bf16_t* yb = WSH(YCATB);
    *(uint2*)(yb + gt_off<16>(t, lane * 4)) = make_uint2(pack2bf(v0.x * i0 * gs0.x, v0.y * i0 * gs0.y), pack2bf(v0.z * i0 * gs0.z, v0.w * i0 * gs0.w));
    *(uint2*)(yb + gt_off<16>(t, lane * 4 + 256)) = make_uint2(pack2bf(v1.x * i0 * gs1.x, v1.y * i0 * gs1.y), pack2bf(v1.z * i0 * gs1.z, v1.w * i0 * gs1.w));
    *(uint2*)(yb + gt_off<16>(t, lane * 4 + 512)) = make_uint2(pack2bf(mo.x * i1 * gm.x, mo.y * i1 * gm.y), pack2bf(mo.z * i1 * gm.z, mo.w * i1 * gm.w));
    *(uint2*)(yb + gt_off<16>(t, lane * 4 + 768)) = make_uint2(pack2bf(sw.x * i2 * gw.x, sw.y * i2 * gw.y), pack2bf(sw.z * i2 * gw.z, sw.w * i2 * gw.w));
  }
}


__device__ __forceinline__ void phase_moba_gate(const Params& p) {
  const int gtid = blockIdx.x * NTHR + TIDX, gsz = gridDim.x * NTHR;
  for (int idx = gtid; idx < T * 4; idx += gsz) {
    const int hh = idx / T, t = idx % T, b = t / S, s = t & (S - 1), blk = s >> 8;
    float4 q[16];
    const float4* qp = (const float4*)(WSF(PROJ) + (size_t)t * NIN + C_MQ + hh * 64);
#pragma unroll
    for (int i = 0; i < 16; ++i) q[i] = qp[i];
    float v0 = -INFINITY, v1 = -INFINITY, v2 = -INFINITY; int i0 = 63, i1 = 63, i2 = 63;
#pragma unroll 2
    for (int n = 0; n < blk; ++n) {
      const float4* kp = (const float4*)(WSF(KMEAN) + ((b * 4 + hh) * 32 + n) * 64);
      float gsc = 0.f;
#pragma unroll
      for (int i = 0; i < 16; ++i) { const float4 k = kp[i]; gsc += q[i].x * k.x + q[i].y * k.y + q[i].z * k.z + q[i].w * k.w; }
      if (gsc > v0) { v2 = v1; i2 = i1; v1 = v0; i1 = i0; v0 = gsc; i0 = n; }
      else if (gsc > v1) { v2 = v1; i2 = i1; v1 = gsc; i1 = n; }
      else if (gsc > v2) { v2 = gsc; i2 = n; }
    }
    WSI(MSEL)[(size_t)t * 4 + hh] = i0 | (i1 << 6) | (i2 << 12);
  }
}

struct AttnSt { f32x16 o0, o1; float m, l; };
struct KFrag { bf16x8 a0, a1, a2, a3, b0, b1, b2, b3; };
__device__ __forceinline__ void attn_loadK(KFrag& f, const bf16_t* __restrict__ Kt, int ldk, int kt0, int lane) {
  (void)ldk;
  const bf16_t* kp = Kt + (size_t)(kt0 >> 6) * 4096 + lane * 8;
  f.a0 = *(const bf16x8*)(kp); f.a1 = *(const bf16x8*)(kp + 512); f.a2 = *(const bf16x8*)(kp + 1024); f.a3 = *(const bf16x8*)(kp + 1536);
  f.b0 = *(const bf16x8*)(kp + 2048); f.b1 = *(const bf16x8*)(kp + 2560); f.b2 = *(const bf16x8*)(kp + 3072); f.b3 = *(const bf16x8*)(kp + 3584);
}
__device__ __forceinline__ bf16x8 pk8(float a, float b, float c, float d, float e, float f, float g, float hh) {
  const unsigned w0 = pack2bf(a, b), w1 = pack2bf(c, d), w2 = pack2bf(e, f), w3 = pack2bf(g, hh);
  typedef unsigned u32x4 __attribute__((ext_vector_type(4)));
  const u32x4 u = {w0, w1, w2, w3};
  return __builtin_bit_cast(bf16x8, u);
}
template <int MODE>
__device__ __forceinline__ void attn_compute(KFrag& kf, const bf16_t* __restrict__ Kb, int ldk, int kt_next, const bf16_t* __restrict__ Vtb, int kt0, const bf16x8 (&qf)[4], int lo, int hi, float c, int lane, AttnSt& st) {
  const int h = lane >> 5, r31 = lane & 31;
  const bf16_t* vp = Vtb + (size_t)(kt0 >> 6) * 4096 + lane * 4;
  const bf16_t* vq = vp + 256;
  bf16x4 va[8], vb[8];
#pragma unroll
  for (int i = 0; i < 8; ++i) va[i] = *(const bf16x4*)(vp + i * 512);
  f32x16 s0, s1;
#pragma unroll
  for (int r = 0; r < 16; ++r) { s0[r] = 0.f; s1[r] = 0.f; }
  s0 = __builtin_amdgcn_mfma_f32_32x32x16_bf16(kf.a0, qf[0], s0, 0, 0, 0); s1 = __builtin_amdgcn_mfma_f32_32x32x16_bf16(kf.b0, qf[0], s1, 0, 0, 0);
  s0 = __builtin_amdgcn_mfma_f32_32x32x16_bf16(kf.a1, qf[1], s0, 0, 0, 0); s1 = __builtin_amdgcn_mfma_f32_32x32x16_bf16(kf.b1, qf[1], s1, 0, 0, 0);
  s0 = __builtin_amdgcn_mfma_f32_32x32x16_bf16(kf.a2, qf[2], s0, 0, 0, 0); s1 = __builtin_amdgcn_mfma_f32_32x32x16_bf16(kf.b2, qf[2], s1, 0, 0, 0);
  s0 = __builtin_amdgcn_mfma_f32_32x32x16_bf16(kf.a3, qf[3], s0, 0, 0, 0); s1 = __builtin_amdgcn_mfma_f32_32x32x16_bf16(kf.b3, qf[3], s1, 0, 0, 0);
  __builtin_amdgcn_sched_barrier(0);
  attn_loadK(kf, Kb, ldk, kt_next, lane);
#pragma unroll
  for (int i = 0; i < 8; ++i) vb[i] = *(const bf16x4*)(vq + i * 512);
  float tmax = -INFINITY;
  if (MODE == 1) {
    const int klo = lo - kt0 - 4 * h, khi = hi - kt0 - 4 * h;
#pragma unroll
    for (int r = 0; r < 16; ++r) {
      const int k0c = (r & 3) + 8 * (r >> 2);
      s0[r] = (k0c >= klo && k0c <= khi) ? s0[r] : -INFINITY;
      s1[r] = (k0c + 32 >= klo && k0c + 32 <= khi) ? s1[r] : -INFINITY;
    }
  }
#pragma unroll
  for (int r = 0; r < 16; ++r) tmax = fmaxf(tmax, fmaxf(s0[r], s1[r]));
  tmax = fmaxf(tmax, __shfl_xor(tmax, 32));
  const float mnew = fmaxf(st.m, tmax * c);
  const float msafe = (mnew == -INFINITY) ? 0.f : mnew;
  const float alpha = __builtin_amdgcn_exp2f(st.m - msafe);
  st.m = mnew;
  float psum = 0.f;
#pragma unroll
  for (int r = 0; r < 16; ++r) {
    s0[r] = __builtin_amdgcn_exp2f(fmaf(s0[r], c, -msafe));
    s1[r] = __builtin_amdgcn_exp2f(fmaf(s1[r], c, -msafe));
    psum += s0[r] + s1[r];
  }
  st.l = st.l * alpha + psum;
  if (__any(alpha != 1.f)) {
#pragma unroll
    for (int r = 0; r < 16; ++r) { st.o0[r] *= alpha; st.o1[r] *= alpha; }
  }
  const bf16x8 p0 = pk8(s0[0], s0[1], s0[2], s0[3], s0[4], s0[5], s0[6], s0[7]);
  const bf16x8 p1 = pk8(s0[8], s0[9], s0[10], s0[11], s0[12], s0[13], s0[14], s0[15]);
  const bf16x8 p2 = pk8(s1[0], s1[1], s1[2], s1[3], s1[4], s1[5], s1[6], s1[7]);
  const bf16x8 p3 = pk8(s1[8], s1[9], s1[10], s1[11], s1[12], s1[13], s1[14], s1[15]);
#define VF(x, i) ((bf16x8){x[2 * i][0], x[2 * i][1], x[2 * i][2], x[2 * i][3], x[2 * i + 1][0], x[2 * i + 1][1], x[2 * i + 1][2], x[2 * i + 1][3]})
  st.o0 = __builtin_amdgcn_mfma_f32_32x32x16_bf16(VF(va, 0), p0, st.o0, 0, 0, 0); st.o1 = __builtin_amdgcn_mfma_f32_32x32x16_bf16(VF(vb, 0), p0, st.o1, 0, 0, 0);
  st.o0 = __builtin_amdgcn_mfma_f32_32x32x16_bf16(VF(va, 1), p1, st.o0, 0, 0, 0); st.o1 = __builtin_amdgcn_mfma_f32_32x32x16_bf16(VF(vb, 1), p1, st.o1, 0, 0, 0);
  st.o0 = __builtin_amdgcn_mfma_f32_32x32x16_bf16(VF(va, 2), p2, st.o0, 0, 0, 0); st.o1 = __builtin_amdgcn_mfma_f32_32x32x16_bf16(VF(vb, 2), p2, st.o1, 0, 0, 0);
  st.o0 = __builtin_amdgcn_mfma_f32_32x32x16_bf16(VF(va, 3), p3, st.o0, 0, 0, 0); st.o1 = __builtin_amdgcn_mfma_f32_32x32x16_bf16(VF(vb, 3), p3, st.o1, 0, 0, 0);
#undef VF
}
template <int MODE>
__device__ __forceinline__ void attn_run(const bf16_t* __restrict__ Kb, int ldk, const bf16_t* __restrict__ Vtb, int kt_first, int ntiles, const bf16x8 (&qf)[4], int lo, int hi, float c, int lane, AttnSt& st) {
  KFrag kf;
  attn_loadK(kf, Kb, ldk, kt_first, lane);
#pragma unroll 1
  for (int i = 0; i < ntiles; ++i) {
    const int ktn = (i + 1 < ntiles) ? kt_first + 64 * (i + 1) : kt_first;
    attn_compute<MODE>(kf, Kb, ldk, ktn, Vtb, kt_first + 64 * i, qf, lo, hi, c, lane, st);
  }
}
__device__ __forceinline__ void attn_init(AttnSt& st) {
#pragma unroll
  for (int r = 0; r < 16; ++r) { st.o0[r] = 0.f; st.o1[r] = 0.f; }
  st.m = -INFINITY; st.l = 0.f;
}
__device__ __forceinline__ void attn_store(const AttnSt& st, float scale, float* outp, int h) {
#pragma unroll
  for (int g = 0; g < 4; ++g) {
    *(float4*)(outp + g * 8 + 4 * h) = make_float4(st.o0[g * 4 + 0] * scale, st.o0[g * 4 + 1] * scale, st.o0[g * 4 + 2] * scale, st.o0[g * 4 + 3] * scale);
    *(float4*)(outp + 32 + g * 8 + 4 * h) = make_float4(st.o1[g * 4 + 0] * scale, st.o1[g * 4 + 1] * scale, st.o1[g * 4 + 2] * scale, st.o1[g * 4 + 3] * scale);
  }
}
__device__ __forceinline__ void phase_attn2(const Params& p, int l, char* smem) {
  const int tid = TIDX, lane = tid & 63, w = tid >> 6, h = lane >> 5, ql = lane & 31;
  const float c = 0.125f * 1.4426950408889634f;
  volatile unsigned short* qlist = (volatile unsigned short*)(smem + 65536) + w * 128;
  const int gw = blockIdx.x * (NTHR / 64) + w, nw = gridDim.x * (NTHR / 64);
  constexpr int NPAST = 2 * 8 * 496, NOWN = 2048, NSWA = 2048;
  for (int itb = 0;; ++itb) {
    const int nb_ = (int)gridDim.x, brank = itb * nb_ + ((itb & 1) ? (nb_ - 1 - (int)blockIdx.x) : (int)blockIdx.x);
    if (brank >= 8 * 271) break;
    {
      const int bh = brank & 7, r_ = brank >> 3, b = bh >> 2, hh = bh & 3;
      int pp = (int)((-1.f + sqrtf(1.f + 4.f * (float)r_)) * 0.5f);
      while (pp * (pp + 1) > r_) --pp;
      while ((pp + 1) * (pp + 2) <= r_) ++pp;
      const int j = r_ - pp * (pp + 1), qb = 2 * pp + 1 + (w >> 1), qh = w & 1;
      __syncthreads();
      {
        const uint4* gk = (const uint4*)(WSH(MKT) + ((size_t)bh * 128 + j * 4) * 4096);
        const uint4* gv = (const uint4*)(WSH(MVT) + ((size_t)bh * 128 + j * 4) * 4096);
        uint4 tk[8], tv[8];
#pragma unroll
        for (int i = 0; i < 8; ++i) { tk[i] = gk[tid + i * NTHR]; tv[i] = gv[tid + i * NTHR]; }
#pragma unroll
        for (int i = 0; i < 8; ++i) { ((uint4*)smem)[tid + i * NTHR] = tk[i]; ((uint4*)(smem + 32768))[tid + i * NTHR] = tv[i]; }
      }
      __syncthreads();
      if (qb > 31 || j >= qb) continue;
      int n = 0;
#pragma unroll
      for (int g = 2 * qh; g < 2 * qh + 2; ++g) {
        const int ms = WSI(MSEL)[((size_t)b * S + qb * 256 + g * 64 + lane) * 4 + hh];
        const int slot = ((ms & 63) == j) ? 0 : ((((ms >> 6) & 63) == j) ? 1 : ((((ms >> 12) & 63) == j) ? 2 : -1));
        const unsigned long long mask = __ballot(slot >= 0);
        const int pos = n + __popcll(mask & ((1ull << lane) - 1ull));
        if (slot >= 0) qlist[pos] = (unsigned short)((g * 64 + lane) | (slot << 8));
        n += __popcll(mask);
      }
      if (n == 0) continue;
      const bf16_t* Kb = (const bf16_t*)smem;
      const bf16_t* Vtb = (const bf16_t*)(smem + 32768);
      for (int qt = 0; qt * 32 < n; ++qt) {
        const int idx = qt * 32 + ql;
        const bool valid = idx < n;
        const unsigned ent = qlist[valid ? idx : 0];
        const size_t t = (size_t)b * S + qb * 256 + (ent & 255u);
        bf16x8 qf[4];
#pragma unroll
        for (int ks = 0; ks < 4; ++ks) qf[ks] = *(const bf16x8*)(WSH(MQK) + t * 512 + hh * 64 + 16 * ks + 8 * h);
        AttnSt st; attn_init(st);
        attn_run<0>(Kb, 512, Vtb, 0, 4, qf, 0, 0, c, lane, st);
        const float lt = st.l + __shfl_xor(st.l, 32);
        if (valid) {
          const size_t base = (t * 4 + hh) * 4 + (ent >> 8);
          attn_store(st, 1.f, WSF(PARTO) + base * 64, h);
          if (h == 0) *(float2*)(WSF(PARTML) + base * 2) = make_float2(st.m, lt);
        }
      }
    }
  }
  for (int it = 0;; ++it) {
    const int rank = NPAST + it * nw + ((it & 1) ? (nw - 1 - gw) : gw);
    if (rank >= NPAST + NOWN + NSWA) break;
    if (rank < NPAST + NOWN) {
      const int r2 = rank - NPAST, sub = 7 - (r2 >> 8), bh = r2 & 7, blk = (r2 >> 3) & 31, b = bh >> 2, hh = bh & 3;
      const int q0 = blk * 256 + sub * 32, n_own = (sub * 32 + 31) / 64 + 1;
      const size_t t = (size_t)b * S + q0 + ql;
      bf16x8 qf[4];
#pragma unroll
      for (int ks = 0; ks < 4; ++ks) qf[ks] = *(const bf16x8*)(WSH(MQK) + t * 512 + hh * 64 + 16 * ks + 8 * h);
      AttnSt st; attn_init(st);
      attn_run<1>(WSH(MKT) + (size_t)(b * 4 + hh) * 64 * S, 512, WSH(MVT) + (size_t)(b * 4 + hh) * 64 * S, blk * 256, n_own, qf, 0, q0 + ql, c, lane, st);
      const float lt = st.l + __shfl_xor(st.l, 32);
      const size_t base = (t * 4 + hh) * 4 + 3;
      attn_store(st, 1.f, WSF(PARTO) + base * 64, h);
      if (h == 0) *(float2*)(WSF(PARTML) + base * 2) = make_float2(st.m, lt);
    } else {
      const int r3 = rank - NPAST - NOWN, qt = r3 & 255, hq = (r3 >> 8) & 3, kvh = hq >> 1, b = r3 >> 10, q0 = qt * 32;
      const size_t t = (size_t)b * S + q0 + ql;
      bf16x8 qf[4];
#pragma unroll
      for (int ks = 0; ks < 4; ++ks) qf[ks] = *(const bf16x8*)(WSH(SQK) + t * 384 + hq * 64 + 16 * ks + 8 * h);
      const int first = (q0 >= 127 ? q0 - 127 : 0) >> 6, last = (q0 + 31) >> 6;
      AttnSt st; attn_init(st);
      attn_run<1>(WSH(SKT) + (size_t)(b * 2 + kvh) * 64 * S, 384, WSH(SVT) + (size_t)(b * 2 + kvh) * 64 * S, first * 64, last - first + 1, qf, q0 + ql - 127, q0 + ql, c, lane, st);
      const float lt = st.l + __shfl_xor(st.l, 32);
      const float sinkv = p.swa_sinks[l * 4 + hq] * 1.4426950408889634f;
      const float M = fmaxf(st.m, sinkv), f = __builtin_amdgcn_exp2f(st.m - M);
      const float L = lt * f + __builtin_amdgcn_exp2f(sinkv - M);
      attn_store(st, f / L, WSF(YCAT) + t * 1024 + 768 + hq * 64, h);
    }
  }
}


__device__ __forceinline__ unsigned fkey(float v) { const unsigned u = __float_as_uint(v); return (u & 0x80000000u) ? ~u : (u | 0x80000000u); }
template <unsigned MASK> __device__ __forceinline__ float kval(unsigned k) {
  const unsigned u = (k & 0x80000000u) ? (k & 0x7fffffffu) : ~k;
  return __uint_as_float(u & ~MASK);
}
__device__ __forceinline__ void ins16(unsigned (&L)[16], unsigned x) {
#pragma unroll
  for (int j = 0; j < 16; ++j) { const unsigned hi = max(L[j], x); x = min(L[j], x); L[j] = hi; }
}
__device__ __forceinline__ void ce_desc(unsigned& hi, unsigned& lo) { const unsigned a = max(hi, lo), b = min(hi, lo); hi = a; lo = b; }
__device__ __forceinline__ void sort16_desc(unsigned (&v)[16]) {
#pragma unroll
  for (int k = 2; k <= 16; k <<= 1)
#pragma unroll
    for (int j = k >> 1; j > 0; j >>= 1)
#pragma unroll
      for (int i = 0; i < 16; ++i) {
        const int l = i ^ j;
        if (l > i) { if ((i & k) == 0) ce_desc(v[i], v[l]); else ce_desc(v[l], v[i]); }
      }
}
__device__ __forceinline__ void top16_merge(unsigned (&a)[16], const unsigned (&b)[16]) {
#pragma unroll
  for (int i = 0; i < 16; ++i) a[i] = max(a[i], b[15 - i]);
#pragma unroll
  for (int j = 8; j > 0; j >>= 1)
#pragma unroll
    for (int i = 0; i < 16; ++i) { const int l = i ^ j; if (l > i) ce_desc(a[i], a[l]); }
}
__device__ __forceinline__ unsigned csel(unsigned cond, unsigned a, unsigned b) {
  unsigned r;
  asm("v_cmp_ne_u32 vcc, 0, %1\n\tv_cndmask_b32 %0, %2, %3, vcc" : "=v"(r) : "v"(cond), "v"(a), "v"(b) : "vcc");
  return r;
}
__device__ __forceinline__ unsigned sel16(const unsigned (&A)[16], unsigned a) {
  const unsigned b0 = a & 1u, b1 = a & 2u, b2 = a & 4u, b3 = a & 8u;
  const unsigned t0 = csel(b0, A[0], A[1]), t1 = csel(b0, A[2], A[3]), t2 = csel(b0, A[4], A[5]), t3 = csel(b0, A[6], A[7]);
  const unsigned t4 = csel(b0, A[8], A[9]), t5 = csel(b0, A[10], A[11]), t6 = csel(b0, A[12], A[13]), t7 = csel(b0, A[14], A[15]);
  const unsigned u0 = csel(b1, t0, t1), u1 = csel(b1, t2, t3), u2 = csel(b1, t4, t5), u3 = csel(b1, t6, t7);
  const unsigned w0 = csel(b2, u0, u1), w1 = csel(b2, u2, u3);
  return csel(b3, w0, w1);
}
__device__ __forceinline__ unsigned sel16_packed(unsigned w0, unsigned w1, unsigned w2, unsigned w3, unsigned a) {
  const unsigned lo = csel(a & 4u, w0, w1), hi = csel(a & 4u, w2, w3), w = csel(a & 8u, lo, hi);
  return (w >> ((a & 3u) * 8u)) & 0xffu;
}
__device__ __forceinline__ void peer_half_top16(const char* kmat, const bf16_t* qcol, const int (&aoff)[8], int h4, unsigned (&L)[16]) {
  bf16x8 bq[8];
#pragma unroll
  for (int s = 0; s < 8; ++s) bq[s] = *(const bf16x8*)(qcol + s * 8);
#pragma unroll
  for (int j = 0; j < 16; ++j) L[j] = 0u;
#pragma unroll
  for (int nt = 0; nt < 4; ++nt) {
    f32x16 acc;
#pragma unroll
    for (int r = 0; r < 16; ++r) acc[r] = 0.f;
#pragma unroll
    for (int s = 0; s < 8; ++s) {
      const bf16x8 ak = *(const bf16x8*)(kmat + nt * 8192 + aoff[s]);
      acc = __builtin_amdgcn_mfma_f32_32x32x16_bf16(ak, bq[s], acc, 0, 0, 0);
    }
    unsigned kt[16];
#pragma unroll
    for (int r = 0; r < 16; ++r) {
      const int nconst = nt * 32 + (r & 3) + 8 * (r >> 2);
      kt[r] = (fkey(acc[r]) & ~127u) | (unsigned)(127 - nconst - h4);
    }
    sort16_desc(kt);
    if (nt == 0) {
#pragma unroll
      for (int j = 0; j < 16; ++j) L[j] = kt[j];
    } else top16_merge(L, kt);
    __builtin_amdgcn_sched_barrier(0);
  }
  unsigned P[16];
#pragma unroll
  for (int j = 0; j < 16; ++j) P[j] = __shfl_xor(L[j], 32);
  top16_merge(L, P);
}
__device__ __forceinline__ void phase_peer_topk2(const Params& p, int l, char* smem) {
  const int tid = TIDX, lane = tid & 63;
  {
    const uint4* ksrc = (const uint4*)(WSH(K12B) + (size_t)l * 32768);
    for (int i = tid; i < 4096; i += NTHR) {
      const int mat = i >> 11, r = (i >> 4) & 127, c = i & 15;
      *(uint4*)(smem + mat * 32768 + r * 256 + ((c ^ (r & 15)) << 4)) = ksrc[i];
    }
  }
  __syncthreads();
  const int h = lane >> 5, cl = lane & 31;
  int aoff[8];
#pragma unroll
  for (int s = 0; s < 8; ++s) aoff[s] = cl * 256 + ((((h * 8) ^ (lane & 15)) ^ s) << 4);
  const int gw = (blockIdx.x * NTHR + tid) >> 6, nw = gridDim.x * (NTHR / 64);
  for (int unit = gw; unit < T * 8 / 32; unit += nw) {
    const size_t col = (size_t)unit * 32 + cl;
    const bf16_t* qcol = WSH(QB) + col * 256 + h * 64;
    unsigned L1[16], L2[16];
    peer_half_top16(smem, qcol, aoff, 4 * h, L1);
    peer_half_top16(smem + 32768, qcol + 128, aoff, 4 * h, L2);
    float v1[16], v2[16];
#pragma unroll
    for (int j = 0; j < 16; ++j) { v1[j] = kval<127u>(L1[j]); v2[j] = kval<127u>(L2[j]); }
#define CKEY(a, b) ((fkey(v1[a] + v2[b]) & ~255u) | (unsigned)(255 - ((a) * 16 + (b))))
    unsigned C[16];
#pragma unroll
    for (int b = 0; b < 16; ++b) C[b] = CKEY(0, b);
    __builtin_amdgcn_sched_barrier(0);
#pragma unroll
    for (int a = 1; a <= 4; ++a) {
      unsigned R[16];
#pragma unroll
      for (int b = 0; b < 16; ++b) R[b] = (b < 16 / (a + 1)) ? CKEY(a, b) : 0u;
      top16_merge(C, R);
      __builtin_amdgcn_sched_barrier(0);
    }
#pragma unroll
    for (int a = 5; a < 16; ++a) {
#pragma unroll
      for (int b = 0; b < 16 / (a + 1); ++b) ins16(C, CKEY(a, b));
      if (a & 1) __builtin_amdgcn_sched_barrier(0);
    }
#undef CKEY
    unsigned P1[4], P2[4];
#pragma unroll
    for (int k = 0; k < 4; ++k) {
      P1[k] = (L1[4 * k] & 127u) | ((L1[4 * k + 1] & 127u) << 8) | ((L1[4 * k + 2] & 127u) << 16) | ((L1[4 * k + 3] & 127u) << 24);
      P2[k] = (L2[4 * k] & 127u) | ((L2[4 * k + 1] & 127u) << 8) | ((L2[4 * k + 2] & 127u) << 16) | ((L2[4 * k + 3] & 127u) << 24);
    }
    float ex[16]; unsigned ee[16]; float sum = 0.f;
    const float mx = kval<255u>(C[0]);
#pragma unroll
    for (int k = 0; k < 16; ++k) {
      const unsigned ci = 255u - (C[k] & 255u);
      ee[k] = (127u - sel16_packed(P1[0], P1[1], P1[2], P1[3], ci >> 4)) * 128u + (127u - sel16_packed(P2[0], P2[1], P2[2], P2[3], ci & 15u));
      ex[k] = __expf(kval<255u>(C[k]) - mx);
      sum += ex[k];
    }
    const float inv = 1.f / sum;
    unsigned* dst = h ? (unsigned*)(WSF(GVAL) + col * 16) : (unsigned*)(WSI(EIDX) + col * 16);
#pragma unroll
    for (int k4 = 0; k4 < 4; ++k4) {
      uint4 w;
      w.x = h ? __float_as_uint(ex[4 * k4 + 0] * inv) : ee[4 * k4 + 0];
      w.y = h ? __float_as_uint(ex[4 * k4 + 1] * inv) : ee[4 * k4 + 1];
      w.z = h ? __float_as_uint(ex[4 * k4 + 2] * inv) : ee[4 * k4 + 2];
      w.w = h ? __float_as_uint(ex[4 * k4 + 3] * inv) : ee[4 * k4 + 3];
      *(uint4*)(dst + 4 * k4) = w;
    }
  }
  __syncthreads();
}


typedef float f32x2 __attribute__((ext_vector_type(2)));
__device__ __forceinline__ float dot16_fp8(const uint4 w, const float (&h)[16]) {
  float s = 0.f;
  const unsigned ww[4] = {w.x, w.y, w.z, w.w};
#pragma unroll
  for (int i = 0; i < 4; ++i) {
    const f32x2 lo = __builtin_amdgcn_cvt_pk_f32_fp8((int)ww[i], false), hi = __builtin_amdgcn_cvt_pk_f32_fp8((int)ww[i], true);
    s += lo[0] * h[4 * i] + lo[1] * h[4 * i + 1] + hi[0] * h[4 * i + 2] + hi[1] * h[4 * i + 3];
  }
  return s;
}
__device__ __forceinline__ void axpy16_fp8(float a, const uint4 w, float (&acc)[16]) {
  const unsigned ww[4] = {w.x, w.y, w.z, w.w};
#pragma unroll
  for (int i = 0; i < 4; ++i) {
    const f32x2 lo = __builtin_amdgcn_cvt_pk_f32_fp8((int)ww[i], false), hi = __builtin_amdgcn_cvt_pk_f32_fp8((int)ww[i], true);
    acc[4 * i] += a * lo[0]; acc[4 * i + 1] += a * lo[1]; acc[4 * i + 2] += a * hi[0]; acc[4 * i + 3] += a * hi[1];
  }
}

struct PeerDist { int first, count, slice0, nslice; };
__device__ __forceinline__ PeerDist peer_dist(unsigned xcc, unsigned nloc, unsigned nx, unsigned rank, int w) {
  PeerDist d;
  if (nx == 8u && xcc < 8u) { d.first = (int)rank * (NTHR / 64) + w; d.count = (int)nloc * (NTHR / 64); d.slice0 = (int)xcc; d.nslice = 1; }
  else { d.first = (int)blockIdx.x * (NTHR / 64) + w; d.count = (int)gridDim.x * (NTHR / 64); d.slice0 = 0; d.nslice = 8; }
  return d;
}
__device__ __forceinline__ void peer_gather8(uint4 (&r)[8], const unsigned char* __restrict__ tab, int eh, int colbyte, int g) {
#pragma unroll
  for (int j = 0; j < 8; ++j) {
    const int e = __shfl(eh, j * 8 + g);
    r[j] = *(const uint4*)(tab + (size_t)e * 128 + colbyte);
  }
}
__device__ __forceinline__ void phase_peer_u(const Params& p, int l, const PeerDist dist) {
  const int lane = TIDX & 63, g = lane >> 3, sub = lane & 7;
  for (int sl = dist.slice0; sl < dist.slice0 + dist.nslice; ++sl) {
    const unsigned char* U = (const unsigned char*)(p.ws + OFF_UB) + ((size_t)(l * 8 + sl)) * 16384 * 128 + sub * 16;
    const int colb = sl * 128 + sub * 16, step = dist.count;
    const int n = (dist.first < T) ? (T - 1 - dist.first) / step + 1 : 0;
    if (n == 0) continue;
    uint4 rA[8], rB[8];
    int e0 = WSI(EIDX)[(size_t)dist.first * 128 + lane], e1 = WSI(EIDX)[(size_t)dist.first * 128 + 64 + lane];
    peer_gather8(rA, U, e0, 0, g);
#pragma unroll 1
    for (int i = 0; i < n; ++i) {
      const int t = dist.first + i * step, tn = dist.first + (i + 1 < n ? i + 1 : i) * step;
      peer_gather8(rB, U, e1, 0, g);
      const int ne0 = WSI(EIDX)[(size_t)tn * 128 + lane], ne1 = WSI(EIDX)[(size_t)tn * 128 + 64 + lane];
      float h[16];
      {
        const uint4 ha = *(const uint4*)(WSH(HB) + gt_off<16>(t, colb)), hb = *(const uint4*)(WSH(HB) + gt_off<16>(t, colb + 8));
        h[0] = bflo(ha.x); h[1] = bfhi(ha.x); h[2] = bflo(ha.y); h[3] = bfhi(ha.y); h[4] = bflo(ha.z); h[5] = bfhi(ha.z); h[6] = bflo(ha.w); h[7] = bfhi(ha.w);
        h[8] = bflo(hb.x); h[9] = bfhi(hb.x); h[10] = bflo(hb.y); h[11] = bfhi(hb.y); h[12] = bflo(hb.z); h[13] = bfhi(hb.z); h[14] = bflo(hb.w); h[15] = bfhi(hb.w);
      }
      __builtin_amdgcn_sched_barrier(0);
      float d0[8], d1[8];
#pragma unroll
      for (int j = 0; j < 8; ++j) d0[j] = dot16_fp8(rA[j], h);
      __builtin_amdgcn_sched_barrier(0);
      peer_gather8(rA, U, ne0, 0, g);
      __builtin_amdgcn_sched_barrier(0);
#pragma unroll
      for (int j = 0; j < 8; ++j) d1[j] = dot16_fp8(rB[j], h);
#pragma unroll
      for (int o = 1; o < 8; o <<= 1) {
#pragma unroll
        for (int j = 0; j < 8; ++j) { d0[j] += __shfl_xor(d0[j], o); d1[j] += __shfl_xor(d1[j], o); }
      }
      float v0 = d0[0], v1 = d1[0];
#pragma unroll
      for (int j = 1; j < 8; ++j) { v0 = (sub == j) ? d0[j] : v0; v1 = (sub == j) ? d1[j] : v1; }
      float* pp = WSF(PP) + ((size_t)sl * T + t) * 128;
      pp[sub * 8 + g] = v0; pp[64 + sub * 8 + g] = v1;
      e0 = ne0; e1 = ne1;
      __builtin_amdgcn_sched_barrier(0);
    }
  }
}
__device__ __forceinline__ void phase_peer_r(const Params& p, int l) {
  const int gtid = blockIdx.x * NTHR + TIDX, gsz = gridDim.x * NTHR;
  const float* SU = WSF(SUV) + (size_t)(l * 2) * 16384; const float* SV = SU + 16384;
  for (int i4 = gtid; i4 < T * 128 / 4; i4 += gsz) {
    float4 s = make_float4(0.f, 0.f, 0.f, 0.f);
#pragma unroll
    for (int x = 0; x < 8; ++x) { const float4 v = ((const float4*)(WSF(PP) + (size_t)x * T * 128))[i4]; s.x += v.x; s.y += v.y; s.z += v.z; s.w += v.w; }
    const int4 e = ((const int4*)WSI(EIDX))[i4];
    const float4 gv = ((const float4*)WSF(GVAL))[i4];
    const float p0 = s.x * SU[e.x], p1 = s.y * SU[e.y], p2 = s.z * SU[e.z], p3 = s.w * SU[e.w];
    float4 o;
    o.x = 0.5f * p0 * (1.f + erff(p0 * 0.70710678118654752f)) * gv.x * SV[e.x];
    o.y = 0.5f * p1 * (1.f + erff(p1 * 0.70710678118654752f)) * gv.y * SV[e.y];
    o.z = 0.5f * p2 * (1.f + erff(p2 * 0.70710678118654752f)) * gv.z * SV[e.z];
    o.w = 0.5f * p3 * (1.f + erff(p3 * 0.70710678118654752f)) * gv.w * SV[e.w];
    ((float4*)WSF(ACT))[i4] = o;
  }
}
__device__ __forceinline__ void phase_peer_v(const Params& p, int l, const PeerDist dist) {
  const int lane = TIDX & 63, g = lane >> 3, sub = lane & 7;
  const float* g2 = WSF(MOD) + (size_t)l * 2 * 6 * D + 5 * D;
  for (int sl = dist.slice0; sl < dist.slice0 + dist.nslice; ++sl) {
    const unsigned char* V = (const unsigned char*)(p.ws + OFF_VB) + ((size_t)(l * 8 + sl)) * 16384 * 128 + sub * 16;
    const int step = dist.count;
    const int n = (dist.first < T) ? (T - 1 - dist.first) / step + 1 : 0;
    if (n == 0) continue;
    uint4 rA[8], rB[8];
    int e0 = WSI(EIDX)[(size_t)dist.first * 128 + lane], e1 = WSI(EIDX)[(size_t)dist.first * 128 + 64 + lane];
    peer_gather8(rA, V, e0, 0, g);
#pragma unroll 1
    for (int i = 0; i < n; ++i) {
      const int t = dist.first + i * step, tn = dist.first + (i + 1 < n ? i + 1 : i) * step;
      peer_gather8(rB, V, e1, 0, g);
      const int ne0 = WSI(EIDX)[(size_t)tn * 128 + lane], ne1 = WSI(EIDX)[(size_t)tn * 128 + 64 + lane];
      const float a0 = WSF(ACT)[(size_t)t * 128 + lane], a1 = WSF(ACT)[(size_t)t * 128 + 64 + lane];
      const int col = sl * 128 + sub * 16 + 2 * g;
      const float2 gt = *(const float2*)(g2 + (t / S) * 6 * D + col);
      float2* xp = (float2*)(WSF(XCUR) + (size_t)t * D + col);
      float2 xv = *xp;
      __builtin_amdgcn_sched_barrier(0);
      float acc[16];
#pragma unroll
      for (int j = 0; j < 16; ++j) acc[j] = 0.f;
#pragma unroll
      for (int j = 0; j < 8; ++j) axpy16_fp8(__shfl(a0, j * 8 + g), rA[j], acc);
      __builtin_amdgcn_sched_barrier(0);
      peer_gather8(rA, V, ne0, 0, g);
      __builtin_amdgcn_sched_barrier(0);
#pragma unroll
      for (int j = 0; j < 8; ++j) axpy16_fp8(__shfl(a1, j * 8 + g), rB[j], acc);
#pragma unroll
      for (int o = 8; o < 64; o <<= 1) {
#pragma unroll
        for (int j = 0; j < 16; ++j) acc[j] += __shfl_xor(acc[j], o);
      }
      float w0 = acc[0], w1 = acc[1];
#pragma unroll
      for (int j = 1; j < 8; ++j) { w0 = (g == j) ? acc[2 * j] : w0; w1 = (g == j) ? acc[2 * j + 1] : w1; }
      xv.x += gt.x * w0; xv.y += gt.y * w1; *xp = xv;
      e0 = ne0; e1 = ne1;
      __builtin_amdgcn_sched_barrier(0);
    }
  }
}

__device__ __forceinline__ void phase_final(const Params& p) {
  const int wave = (blockIdx.x * NTHR + TIDX) >> 6, nw = gridDim.x * (NTHR / 64), lane = TIDX & 63;
  for (int t = wave; t < T; t += nw) {
    const float4* xr = (const float4*)(WSF(XCUR) + (size_t)t * D);
    float4 v[4]; float ss = 0.f;
#pragma unroll
    for (int i = 0; i < 4; ++i) { v[i] = xr[lane + 64 * i]; ss += v[i].x * v[i].x + v[i].y * v[i].y + v[i].z * v[i].z + v[i].w * v[i].w; }
    ss = wave_sum(ss);
    const float inv = rsqrtf(ss * (1.f / D) + 1e-5f);
    float4* orow = (float4*)(p.out + (size_t)t * D);
#pragma unroll
    for (int i = 0; i < 4; ++i) {
      const float4 g4 = *(const float4*)(p.final_g + (lane + 64 * i) * 4);
      orow[lane + 64 * i] = make_float4(v[i].x * inv * g4.x, v[i].y * inv * g4.y, v[i].z * inv * g4.z, v[i].w * inv * g4.w);
    }
  }
}

#define XB_TMO      128
#define XB_XCNT(j)  (256  + 64 * (j))
#define XB_XSUB(j)  (1280 + 64 * (j))
#define XB_XGEN(j)  (2304 + 64 * (j))
#define XB_TOP      3328
#define XB_TOPGEN   3392
#define XCD_BAR_WORDS 3456
#define XB_SPIN_CAP (1u << 18)
__device__ __forceinline__ unsigned xb_ld(unsigned* p)              { return __hip_atomic_load(p, __ATOMIC_RELAXED, __HIP_MEMORY_SCOPE_AGENT); }
__device__ __forceinline__ unsigned xb_add(unsigned* p, unsigned v) { return __hip_atomic_fetch_add(p, v, __ATOMIC_RELAXED, __HIP_MEMORY_SCOPE_AGENT); }
__device__ __forceinline__ unsigned xb_xcc_id() { return (unsigned)__builtin_amdgcn_s_getreg((3 << 11) | 20) & 0xFu; }
#define XB_SPIN(cond, bar) do { unsigned _sp = 0; while (cond) { __builtin_amdgcn_s_sleep(1); \
    if ((++_sp & 255u) == 0u) { if (xb_ld(&(bar)[XB_TMO])) break; if (_sp > XB_SPIN_CAP) { atomicAdd(&(bar)[XB_TMO], 1u); break; } } } } while (0)
struct XcdBarrier { volatile LAS unsigned* st; };
__device__ __forceinline__ XcdBarrier xcd_barrier_post(unsigned* bar, volatile LAS unsigned* st) {
  XcdBarrier b; b.st = st;
  if (threadIdx.x == 0) st[2] = xb_add(&bar[XB_XCNT(xb_xcc_id())], 1u);
  return b;
}
__device__ __forceinline__ void xcd_barrier_complete(unsigned* bar, unsigned x, unsigned& nloc, unsigned& nx) {
  const unsigned G = gridDim.x * gridDim.y * gridDim.z;
  unsigned sum, cnt, mine, sp = 0u;
  for (;;) {
    sum = 0u; cnt = 0u; mine = 0u;
#pragma unroll
    for (unsigned j = 0; j < 16; ++j) { const unsigned c = xb_ld(&bar[XB_XCNT(j)]); sum += c; cnt += (c > 0u) ? 1u : 0u; mine = (j == x) ? c : mine; }
    if (sum == G) break;
    __builtin_amdgcn_s_sleep(1);
    if ((++sp & 255u) == 0u) { if (xb_ld(&bar[XB_TMO])) break; if (sp > XB_SPIN_CAP) { atomicAdd(&bar[XB_TMO], 1u); break; } }
  }
  nloc = mine > 0u ? mine : 1u; nx = cnt > 0u ? cnt : 1u;
}
__device__ __forceinline__ void xcd_barrier(const XcdBarrier& b, char* ws) {
  asm volatile("s_waitcnt vmcnt(0)" ::: "memory");
  __syncthreads();
  if (threadIdx.x == 0) {
    unsigned wlo = __builtin_amdgcn_readfirstlane((unsigned)((unsigned long long)ws & 0xffffffffull));
    unsigned whi = __builtin_amdgcn_readfirstlane((unsigned)((unsigned long long)ws >> 32));
    asm volatile("" : "+s"(wlo), "+s"(whi));
    unsigned* bar = (unsigned*)((char*)(((unsigned long long)whi << 32) | wlo) + OFF_BAR);
    const unsigned x = xb_xcc_id();
    __builtin_amdgcn_s_waitcnt(0);
    unsigned nloc = b.st[0], nx = b.st[1];
    if (nloc == 0u) { xcd_barrier_complete(bar, x, nloc, nx); b.st[0] = nloc; b.st[1] = nx; }
    const unsigned old = xb_add(&bar[XB_XSUB(x)], 1u);
    const unsigned gen = old / nloc;
    if (old + 1u == (gen + 1u) * nloc) {
      __builtin_amdgcn_fence(__ATOMIC_RELEASE, "agent");
      asm volatile("s_waitcnt vmcnt(0)" ::: "memory");
      const unsigned og = xb_add(&bar[XB_TOP], 1u);
      const unsigned tg = og / nx;
      if (og + 1u == (tg + 1u) * nx) xb_add(&bar[XB_TOPGEN], 1u);
      else XB_SPIN(xb_ld(&bar[XB_TOPGEN]) == tg, bar);
      __builtin_amdgcn_fence(__ATOMIC_ACQUIRE, "agent");
      xb_add(&bar[XB_XGEN(x)], 1u);
      asm volatile("s_waitcnt vmcnt(0)" ::: "memory");
    } else {
      XB_SPIN(xb_ld(&bar[XB_XGEN(x)]) == gen, bar);
      __builtin_amdgcn_fence(__ATOMIC_ACQUIRE, "agent");
      asm volatile("s_waitcnt vmcnt(0)" ::: "memory");
    }
  }
  __syncthreads();
}

__device__ __forceinline__ void gsync(cg::grid_group& g) {
  asm volatile("s_waitcnt vmcnt(0)" ::: "memory");
  __syncthreads();
  g.sync();
  __builtin_amdgcn_fence(__ATOMIC_ACQUIRE, "agent");
  asm volatile("s_waitcnt vmcnt(0)" ::: "memory");
}

#ifdef PROBE_MASK
#define XBAR() xcd_barrier(xb, p.ws)
#define PB(id) if ((PROBE_MASK >> (id)) & 1) { pt0 = __builtin_amdgcn_s_memrealtime(); }
#define PE(id) if ((PROBE_MASK >> (id)) & 1) { pacc += __builtin_amdgcn_s_memrealtime() - pt0; }
#define PXB() xcd_barrier(xb, p.ws)
#else
#define XBAR() xcd_barrier(xb, p.ws)
#define PB(id)
#define PE(id)
#define PXB()
#endif
__global__ void __launch_bounds__(NTHR, 2) hymba_fwd(Params p) {
  cg::grid_group grid = cg::this_grid();
  __shared__ __attribute__((aligned(16))) char smem_c[73728];
  float* smem = (float*)smem_c;
  __shared__ uint4 xb_words;
  if (threadIdx.x == 0) xb_words = make_uint4(0u, 0u, 0u, 0u);
  __syncthreads();
  const XcdBarrier xb = xcd_barrier_post((unsigned*)(p.ws + OFF_BAR), (volatile LAS unsigned*)&xb_words);
  unsigned long long pt0 = 0, pacc = 0; (void)pt0; (void)pacc;
  PB(13) phase_mod(p, smem);
  phase_prologue_weights(p, smem);
  if (p.ws == nullptr) gsync(grid);
  XBAR(); PE(13)
#pragma unroll 1
  for (int l = 0; l < NL; ++l) {
    const float* modl = WSF(MOD) + (size_t)l * 2 * 6 * D;
    PB(1) phase_norm_mod(WSF(XCUR), p.norm1_g + l * D, modl + 1 * D, modl + 0 * D, nullptr, WSH(HB));
    XBAR(); PE(1)
    PB(2) gemm_bf16<NINP>(WSH(HB), WSH(WINT) + (size_t)l * NINP * D, EpiInProj{WSF(PROJ), WSH(MQK), WSH(MKT), WSH(MVT), WSH(SQK), WSH(SKT), WSH(SVT)}, smem_c);
    XBAR(); PE(2)
    PB(3) phase_ssd_conv(p, l, smem);
    XBAR(); PE(3)
    PB(4) phase_ssd_states(p, smem); PXB(); PE(4)
    PB(18) phase_moba_gate(p);
    XBAR(); PE(18)
    PB(6) phase_ssd_scan(p); PXB(); PE(6)
    PB(14) phase_attn2(p, l, smem_c);
    XBAR(); PE(14)
    PB(7) phase_ssd_y(p, l, smem);
    XBAR(); PE(7)
    PB(8) phase_mix_norm(p, l);
    XBAR(); PE(8)
    PB(9) gemm_bf16<D>(WSH(YCATB), WSH(WOUTT) + (size_t)l * D * D, EpiResid{WSF(XCUR), modl + 2 * D}, smem_c);
    XBAR(); PE(9)
    PB(1) phase_norm_mod(WSF(XCUR), p.norm2_g + l * D, modl + 4 * D, modl + 3 * D, nullptr, WSH(HB));
    XBAR(); PE(1)
    PB(10) gemm_bf16<2048>(WSH(HB), WSH(WQT) + (size_t)l * 2048 * D, EpiStoreBf16{WSH(QB), 2048}, smem_c);
    XBAR(); PE(10)
    PB(11) phase_peer_topk2(p, l, smem_c);
    XBAR(); PE(11)
    PB(12) {
      const PeerDist dist = peer_dist(xb_xcc_id(), xb_words.x, xb_words.y, xb_words.z, TIDX >> 6);
      PB(15) phase_peer_u(p, l, dist);
      XBAR(); PE(15)
      PB(16) phase_peer_r(p, l);
      XBAR(); PE(16)
      PB(17) phase_peer_v(p, l, dist);
    }
    XBAR(); PE(17) PE(12)
  }
  phase_final(p);
#ifdef PROBE_MASK
  if (blockIdx.x == 0) { const unsigned long long t0 = __builtin_amdgcn_s_memrealtime(); while (__builtin_amdgcn_s_memrealtime() - t0 < pacc) __builtin_amdgcn_s_sleep(8); }
#endif
}

extern "C" void kernel_launch(void* const* d_in, const int* in_sizes, int n_in, void* d_out, int out_size, void* d_ws, size_t ws_size, hipStream_t stream) {
  static int grid_blocks = 0;
  if (!grid_blocks) {
    int dev = 0, cus = 0, per_cu = 0;
    hipGetDevice(&dev);
    hipDeviceGetAttribute(&cus, hipDeviceAttributeMultiprocessorCount, dev);
    hipOccupancyMaxActiveBlocksPerMultiprocessor(&per_cu, hymba_fwd, NTHR, 0);
    if (per_cu > 4) per_cu = 4;
    if (per_cu < 1) per_cu = 1;
    grid_blocks = cus * per_cu;
  }
  Params p;
  memset(&p, 0, sizeof(p));
  const float** ins = (const float**)&p;
  for (int i = 0; i < 23; ++i) ins[i] = (const float*)d_in[i];
  p.out = (float*)d_out;
  p.ws = (char*)d_ws;
  if (ws_size < WS_TOTAL2) fprintf(stderr, "workspace too small: %zu < %zu\n", ws_size, WS_TOTAL);
  hipMemsetAsync(p.ws + OFF_BAR, 0, XCD_BAR_WORDS * 4, stream);
  void* args[] = {&p};
  hipError_t e = hipLaunchCooperativeKernel((void*)hymba_fwd, dim3(grid_blocks), dim3(NTHR), args, 0, stream);
  if (e != hipSuccess) fprintf(stderr, "cooperative launch failed: %s (grid %d)\n", hipGetErrorString(e), grid_blocks);
}
```
